# Optimizing an MI355X kernel written in HIP

```python
import math
import jax, jax.numpy as jnp
from jax import lax
import numpy as np

D_MODEL = 1024
BATCH = 16
SEQ = 2048
DEPTH = 4

HEAD_DIM = 64
N_SB = 4
N_MOBA = 4
N_FOX = 4
N_DSA = 4
BRANCH_W = 4 * HEAD_DIM
N_BRANCH = 4
Q_BLOCK = 128
MOBA_BLOCK = 256
MOBA_TOPK = 3
MOBA_Q_CHUNK = 32
DSA_TOPK = 256
IDX_HEADS = 8
IDX_DIM = 32
T5_BUCKETS = 32
T5_MAX_DIST = 128
D_FF = 2816
CONV_W = 3
RMS_EPS = 1e-6
NEG_BIG = -1e30

IN_SIZES = (
    [BRANCH_W] * 3
    + [BRANCH_W] * 3
    + [BRANCH_W] * 3 + [N_FOX]
    + [BRANCH_W, HEAD_DIM, HEAD_DIM]
    + [IDX_HEADS * IDX_DIM, IDX_DIM, IDX_HEADS]
)
P_IN = int(sum(IN_SIZES))
IN_SPLITS = tuple(int(v) for v in np.cumsum(IN_SIZES)[:-1])

kernel_name = "hybrid_gated_sb_moba_fox_dsa_trunk"


def rmsnorm(x, g):
    xf = x.astype(jnp.float32)
    y = xf * lax.rsqrt(jnp.mean(xf * xf, axis=-1, keepdims=True) + RMS_EPS)
    return (y * g.astype(jnp.float32)).astype(x.dtype)


def to_heads(t, n):
    b, s, _ = t.shape
    return t.reshape(b, s, n, HEAD_DIM).transpose(0, 2, 1, 3)


def merge_heads(o):
    b, h, s, d = o.shape
    return o.transpose(0, 2, 1, 3).reshape(b, s, h * d)


def t5_bucket(n):
    n = jnp.maximum(n, 0)
    max_exact = T5_BUCKETS // 2
    nf = jnp.maximum(n, 1).astype(jnp.float32)
    large = max_exact + (jnp.log(nf / max_exact) / math.log(T5_MAX_DIST / max_exact)
                         * (T5_BUCKETS - max_exact)).astype(jnp.int32)
    large = jnp.minimum(large, T5_BUCKETS - 1)
    return jnp.where(n < max_exact, n, large)


def stick_breaking_attention(q, k, v):
    s_len = q.shape[2]
    scale = HEAD_DIM ** -0.5
    outs = []
    for i in range(s_len // Q_BLOCK):
        t0, t1 = i * Q_BLOCK, (i + 1) * Q_BLOCK
        z = jnp.einsum('bhqd,bhkd->bhqk', q[:, :, t0:t1], k[:, :, :t1]).astype(jnp.float32) * scale
        strict = jnp.arange(t1)[None, :] < jnp.arange(t0, t1)[:, None]
        log_neg = jnp.where(strict, jax.nn.log_sigmoid(-z), 0.0)
        excl = lax.cumsum(log_neg, axis=3, reverse=True) - log_neg
        w = jnp.where(strict, jnp.exp(jax.nn.log_sigmoid(z) + excl), 0.0)
        outs.append(jnp.einsum('bhqk,bhkd->bhqd', w.astype(v.dtype), v[:, :, :t1]))
    return jnp.concatenate(outs, axis=2)


def forgetting_attention(q, k, v, f_logit):
    s_len = q.shape[2]
    scale = HEAD_DIM ** -0.5
    c = jnp.cumsum(jax.nn.log_sigmoid(f_logit.astype(jnp.float32)), axis=1).transpose(0, 2, 1)
    outs = []
    for i in range(s_len // Q_BLOCK):
        t0, t1 = i * Q_BLOCK, (i + 1) * Q_BLOCK
        logits = jnp.einsum('bhqd,bhkd->bhqk', q[:, :, t0:t1], k[:, :, :t1]).astype(jnp.float32) * scale
        logits = logits + c[:, :, t0:t1, None] - c[:, :, None, :t1]
        causal = jnp.arange(t1)[None, :] <= jnp.arange(t0, t1)[:, None]
        p = jax.nn.softmax(jnp.where(causal, logits, NEG_BIG), axis=-1)
        outs.append(jnp.einsum('bhqk,bhkd->bhqd', p.astype(v.dtype), v[:, :, :t1]))
    return jnp.concatenate(outs, axis=2)


def moba_attention(q, k, v, bias_table):
    b, h, s_len, d = q.shape
    scale = HEAD_DIM ** -0.5
    nb = -(-s_len // MOBA_BLOCK)
    pad = nb * MOBA_BLOCK - s_len
    kp = jnp.pad(k, ((0, 0), (0, 0), (0, pad), (0, 0)))
    vp = jnp.pad(v, ((0, 0), (0, 0), (0, pad), (0, 0)))
    kb = kp.reshape(b, h, nb, MOBA_BLOCK, d)
    vb = vp.reshape(b, h, nb, MOBA_BLOCK, d)
    kmean = jnp.mean(kb.astype(jnp.float32), axis=3).astype(k.dtype)
    topk = min(MOBA_TOPK, nb)
    table_t = bias_table.T
    bi = jnp.arange(b)[:, None, None, None]
    hi = jnp.arange(h)[None, :, None, None]

    def chunk(ci):
        t0 = ci * MOBA_Q_CHUNK
        qc = lax.dynamic_slice_in_dim(q, t0, MOBA_Q_CHUNK, axis=2)
        tpos = t0 + jnp.arange(MOBA_Q_CHUNK)
        own = t0 // MOBA_BLOCK
        gate = jnp.einsum('bhqd,bhnd->bhqn', qc, kmean).astype(jnp.float32)
        past = jnp.arange(nb) < own
        gate = jnp.where(past, gate, -jnp.inf)
        _, gidx = lax.top_k(gate, topk)
        sel_valid = gidx < own
        ks = kb[bi, hi, gidx]
        vs = vb[bi, hi, gidx]
        s_sel = jnp.einsum('bhqd,bhqnkd->bhqnk', qc, ks).astype(jnp.float32) * scale
        kpos = gidx[..., None] * MOBA_BLOCK + jnp.arange(MOBA_BLOCK)
        bucket = t5_bucket(tpos[None, None, :, None, None] - kpos)
        s_sel = s_sel + table_t[hi[..., None], bucket].astype(jnp.float32)
        s_sel = jnp.where(sel_valid[..., None], s_sel, NEG_BIG)
        ko = lax.dynamic_slice_in_dim(kp, own * MOBA_BLOCK, MOBA_BLOCK, axis=2)
        vo = lax.dynamic_slice_in_dim(vp, own * MOBA_BLOCK, MOBA_BLOCK, axis=2)
        kpos_own = own * MOBA_BLOCK + jnp.arange(MOBA_BLOCK)
        dist_own = tpos[:, None] - kpos_own[None, :]
        s_own = jnp.einsum('bhqd,bhkd->bhqk', qc, ko).astype(jnp.float32) * scale
        s_own = s_own + table_t[:, t5_bucket(dist_own)].astype(jnp.float32)[None]
        s_own = jnp.where(dist_own >= 0, s_own, NEG_BIG)
        logits = jnp.concatenate([s_sel.reshape(b, h, MOBA_Q_CHUNK, topk * MOBA_BLOCK), s_own], axis=-1)
        p = jax.nn.softmax(logits, axis=-1).astype(v.dtype)
        p_sel = p[..., :topk * MOBA_BLOCK].reshape(b, h, MOBA_Q_CHUNK, topk, MOBA_BLOCK)
        p_own = p[..., topk * MOBA_BLOCK:]
        return (jnp.einsum('bhqnk,bhqnkd->bhqd', p_sel, vs)
                + jnp.einsum('bhqk,bhkd->bhqd', p_own, vo))

    out = lax.map(chunk, jnp.arange(s_len // MOBA_Q_CHUNK))
    return out.transpose(1, 2, 0, 3, 4).reshape(b, h, s_len, d)


def dsa_attention(q, k, v, q_idx, k_idx, w_idx, bias_table):
    b, h, s_len, d = q.shape
    scale = HEAD_DIM ** -0.5
    ksel = min(DSA_TOPK, s_len // 4)
    table_t = bias_table.T
    bi = jnp.arange(b)[:, None, None]
    outs = []
    for i in range(s_len // Q_BLOCK):
        t0, t1 = i * Q_BLOCK, (i + 1) * Q_BLOCK
        kk = min(ksel, t1)
        tpos = jnp.arange(t0, t1)
        isc = jax.nn.relu(jnp.einsum('bqhe,bke->bqhk', q_idx[:, t0:t1], k_idx[:, :t1]))
        isc = jnp.einsum('bqh,bqhk->bqk', w_idx[:, t0:t1], isc).astype(jnp.float32)
        admissible = jnp.arange(t1)[None, :] <= tpos[:, None]
        _, idx = lax.top_k(jnp.where(admissible, isc, -jnp.inf), kk)
        dist = tpos[None, :, None] - idx
        ks = k[bi, idx]
        vs = v[bi, idx]
        logits = jnp.einsum('bhqd,bqkd->bhqk', q[:, :, t0:t1], ks).astype(jnp.float32) * scale
        logits = logits + table_t[:, t5_bucket(dist)].transpose(1, 0, 2, 3).astype(jnp.float32)
        logits = jnp.where((dist >= 0)[:, None], logits, NEG_BIG)
        p = jax.nn.softmax(logits, axis=-1).astype(v.dtype)
        outs.append(jnp.einsum('bhqk,bqkd->bhqd', p, vs))
    return jnp.concatenate(outs, axis=2)


def token_mixer(xn, w_in, fox_b_f, t5_bias, w_gate, w_branch, w_out):
    b, s_len, _ = xn.shape
    proj = xn @ w_in
    (sb_q, sb_k, sb_v, mb_q, mb_k, mb_v, fx_q, fx_k, fx_v, fx_f,
     ds_q, ds_k, ds_v, ix_q, ix_k, ix_w) = jnp.split(proj, IN_SPLITS, axis=-1)
    o_sb = stick_breaking_attention(to_heads(sb_q, N_SB), to_heads(sb_k, N_SB), to_heads(sb_v, N_SB))
    o_mb = moba_attention(to_heads(mb_q, N_MOBA), to_heads(mb_k, N_MOBA), to_heads(mb_v, N_MOBA),
                          t5_bias[:, :N_MOBA])
    o_fx = forgetting_attention(to_heads(fx_q, N_FOX), to_heads(fx_k, N_FOX), to_heads(fx_v, N_FOX),
                                fx_f + fox_b_f)
    o_ds = dsa_attention(to_heads(ds_q, N_DSA), ds_k, ds_v,
                         ix_q.reshape(b, s_len, IDX_HEADS, IDX_DIM), ix_k, ix_w, t5_bias[:, N_MOBA:])
    branches = (o_sb, o_mb, o_fx, o_ds)
    mixed = None
    for i in range(N_BRANCH):
        y = jax.nn.sigmoid(xn @ w_gate[i]) * (merge_heads(branches[i]) @ w_branch[i])
        mixed = y if mixed is None else mixed + y
    return mixed @ w_out


def conv_ffn(xn, w_up, conv_w, conv_b, w_down):
    s_len = xn.shape[1]
    hdn = xn @ w_up
    hp = jnp.pad(hdn, ((0, 0), (CONV_W - 1, 0), (0, 0)))
    acc = conv_b
    for j in range(CONV_W):
        acc = acc + conv_w[j] * hp[:, j:j + s_len]
    g, u = jnp.split(acc, 2, axis=-1)
    return (jax.nn.gelu(g, approximate=False) * u) @ w_down


def setup_inputs(seed: int = 0) -> dict:
    key = jax.random.key(seed)
    ks = jax.random.split(key, 14)
    nrm = jax.random.normal
    f32 = jnp.float32
    return {
        "x": nrm(ks[0], (BATCH, SEQ, D_MODEL), f32),
        "norm_mix_g": 1.0 + 0.02 * nrm(ks[1], (DEPTH, D_MODEL), f32),
        "norm_ffn_g": 1.0 + 0.02 * nrm(ks[2], (DEPTH, D_MODEL), f32),
        "norm_final_g": 1.0 + 0.02 * nrm(ks[3], (D_MODEL,), f32),
        "w_in": nrm(ks[4], (DEPTH, D_MODEL, P_IN), f32) * D_MODEL ** -0.5,
        "fox_b_f": 1.0 + 0.1 * nrm(ks[5], (DEPTH, N_FOX), f32),
        "t5_bias": 0.5 * nrm(ks[6], (T5_BUCKETS, N_MOBA + N_DSA), f32),
        "w_gate": nrm(ks[7], (DEPTH, N_BRANCH, D_MODEL, D_MODEL), f32) * D_MODEL ** -0.5,
        "w_branch": nrm(ks[8], (DEPTH, N_BRANCH, BRANCH_W, D_MODEL), f32) * BRANCH_W ** -0.5,
        "w_out": nrm(ks[9], (DEPTH, D_MODEL, D_MODEL), f32) * D_MODEL ** -0.5,
        "w_up": nrm(ks[10], (DEPTH, D_MODEL, 2 * D_FF), f32) * D_MODEL ** -0.5,
        "conv_w": nrm(ks[11], (DEPTH, CONV_W, 2 * D_FF), f32) * CONV_W ** -0.5,
        "conv_b": 0.01 * nrm(ks[12], (DEPTH, 2 * D_FF), f32),
        "w_down": nrm(ks[13], (DEPTH, D_FF, D_MODEL), f32) * D_FF ** -0.5,
    }


def reference(x, norm_mix_g, norm_ffn_g, norm_final_g, w_in, fox_b_f, t5_bias,
              w_gate, w_branch, w_out, w_up, conv_w, conv_b, w_down):
    for l in range(DEPTH):
        x = x + token_mixer(rmsnorm(x, norm_mix_g[l]), w_in[l], fox_b_f[l], t5_bias,
                            w_gate[l], w_branch[l], w_out[l])
        x = x + conv_ffn(rmsnorm(x, norm_ffn_g[l]), w_up[l], conv_w[l], conv_b[l], w_down[l])
    return rmsnorm(x, norm_final_g)
```

```cpp
#include <hip/hip_runtime.h>
#include <cstdio>
#include <cstdint>
#ifndef MK_N_LAUNCHES
#define MK_N_LAUNCHES 53
#endif
namespace pg8 {
#define PG8_LAS __attribute__((address_space(3)))
typedef unsigned short bf16_t;
typedef short bf16x8 __attribute__((ext_vector_type(8)));
typedef float f32x4 __attribute__((ext_vector_type(4)));
typedef unsigned u32x4 __attribute__((ext_vector_type(4)));
constexpr int BM = 256, BK = 64, HALF = 128, HTB = HALF * BK * 2  , STAGE_BYTES = 8 * HTB, NXCD = 8, WGM = 8;

__host__ __device__ __forceinline__ int lds_byte(int r, int c) { const int st = (r >> 4) * 2 + (c >> 5), rr = r & 15, cc = c & 31, ob = rr * 64 + cc * 2; return st * 1024 + (ob ^ (((ob >> 9) & 1) << 5)); }
__host__ __device__ __forceinline__ void stage_rc(int b, int& R, int& C) { const int st = b / 1024, sb = b % 1024, swz = sb ^ (((sb >> 9) & 1) << 5); R = (st >> 1) * 16 + swz / 64; C = (st & 1) * 32 + (swz % 64) / 2; }
__host__ __device__ __forceinline__ int perm32(int rho) { const int n = rho >> 4, i = rho & 15; return 8 * (i >> 2) + 4 * n + (i & 3); }

struct Unit { int pm, pn; };
struct Gemm { const bf16_t* A; const bf16_t* Bt; int M, N, K; int lda; int a_sh; };

struct StaticOrder {
    int nM, nN, nwg, G, c;
    __host__ __device__ void init(int M, int N, int G_, int c_) { nM = M / BM; nN = N / BM; nwg = nM * nN; G = G_; c = c_; }
    __host__ __device__ bool next(int i, Unit& u) const {
        const long L = (long)i * G + c; if (L >= nwg) return false;
        int wgid = (int)L; { const int q = nwg / NXCD, r = nwg % NXCD, xcd = wgid % NXCD, off = wgid / NXCD; wgid = (xcd < r ? xcd * (q + 1) : r * (q + 1) + (xcd - r) * q) + off; }
        const int nig = WGM * nN, gid = wgid / nig, fm = gid * WGM, gsz = (nM - fm) < WGM ? (nM - fm) : WGM;
        u.pm = fm + ((wgid % nig) % gsz); u.pn = (wgid % nig) / gsz; return true;
    }
    __device__ __forceinline__ void a_ready(const Unit&) const {}
    __device__ __forceinline__ void done(const Unit&) const {}
};

__device__ __forceinline__ unsigned cvt_pk_bf16(float lo, float hi) { unsigned r; asm volatile("v_cvt_pk_bf16_f32 %0, %1, %2" : "=v"(r) : "v"(lo), "v"(hi)); return r; }
typedef float f32x2 __attribute__((ext_vector_type(2)));
__device__ __forceinline__ f32x2 gelu_pk(f32x2 v) {
    const f32x2 av = __builtin_elementwise_abs(v), d = av * 0.2316418882f + 1.0f;
    f32x2 t; t.x = __builtin_amdgcn_rcpf(d.x); t.y = __builtin_amdgcn_rcpf(d.y);
    f32x2 q = t * 0.5307027145f + (-0.7265760135f); q = q * t + 0.7107068705f; q = q * t + (-0.142248368f); q = q * t + 0.127414796f; q = q * t;
    const f32x2 s = (v * v) * (-0.72134752044f);
    f32x2 e; e.x = __builtin_amdgcn_exp2f(s.x); e.y = __builtin_amdgcn_exp2f(s.y);
    const f32x2 m = v * (q * e), r = v - m;
    f32x2 o; o.x = v.x < 0.f ? m.x : r.x; o.y = v.y < 0.f ? m.y : r.y; return o;
}

template <int ACT  > struct EpiBf16 {
    static constexpr bool PERM = true, AFTER_DRAIN = false; static_assert(ACT == 0 || ACT == 1, "EpiBf16: ACT is 0 (none) or 1 (gelu_pk)");
    bf16_t* O; int ldc; const float* bias; int split_cols; size_t split_stride; float scale0;
    __device__ __forceinline__ void operator()(const f32x4 (&acc)[2][2][4][2], const Unit& u, int wr, int wc, int fr, int fq) const {
        const int row0 = u.pm * BM + wr * 64 + fr; int colt = u.pn * BM; bf16_t* base = O;
        float sc = 1.f; if (split_cols) { const int t = colt / split_cols; base += (size_t)t * split_stride; colt -= t * split_cols; if (t == 0) sc = scale0; }
        const int col0 = colt + wc * 32 + 8 * fq, bcol0 = u.pn * BM + wc * 32 + 8 * fq;
        f32x4 bv[2][2];
#pragma unroll
        for (int bj = 0; bj < 2; ++bj)
#pragma unroll
            for (int n = 0; n < 2; ++n) bv[bj][n] = bias ? *(const f32x4*)(bias + bcol0 + bj * HALF + 4 * n) : (f32x4){0.f, 0.f, 0.f, 0.f};
#pragma unroll
        for (int ai = 0; ai < 2; ++ai)
#pragma unroll
            for (int m = 0; m < 4; ++m) { bf16_t* rowp = base + (size_t)(row0 + ai * HALF + m * 16) * ldc + col0;
#pragma unroll
                for (int bj = 0; bj < 2; ++bj) { f32x4 v0 = acc[ai][bj][m][0] + bv[bj][0], v1 = acc[ai][bj][m][1] + bv[bj][1];
                    if (ACT == 1) { f32x2 a = gelu_pk((f32x2){v0[0], v0[1]}), b = gelu_pk((f32x2){v0[2], v0[3]}), c = gelu_pk((f32x2){v1[0], v1[1]}), d = gelu_pk((f32x2){v1[2], v1[3]});
                        v0 = (f32x4){a.x, a.y, b.x, b.y}; v1 = (f32x4){c.x, c.y, d.x, d.y}; }
                    v0 = v0 * sc; v1 = v1 * sc; u32x4 w; w.x = cvt_pk_bf16(v0[0], v0[1]); w.y = cvt_pk_bf16(v0[2], v0[3]); w.z = cvt_pk_bf16(v1[0], v1[1]); w.w = cvt_pk_bf16(v1[2], v1[3]);
                    *(u32x4*)(rowp + bj * HALF) = w; } }
    }
};
struct EpiRes {
    static constexpr bool PERM = false, AFTER_DRAIN = false;
    const float* base; float* out; int ldc;
    __device__ __forceinline__ void operator()(const f32x4 (&acc)[2][2][4][2], const Unit& u, int wr, int wc, int fr, int fq) const {
        const int row0 = u.pm * BM + wr * 64 + fr, col0 = u.pn * BM + wc * 32 + 4 * fq;
#pragma unroll
        for (int ai = 0; ai < 2; ++ai)
#pragma unroll
            for (int m = 0; m < 4; ++m) { const size_t off = (size_t)(row0 + ai * HALF + m * 16) * ldc + col0;
#pragma unroll
                for (int bj = 0; bj < 2; ++bj)
#pragma unroll
                    for (int n = 0; n < 2; ++n) { const f32x4 bs = *(const f32x4*)(base + off + bj * HALF + n * 16); *(f32x4*)(out + off + bj * HALF + n * 16) = bs + acc[ai][bj][m][n]; } }
    }
};
struct EpiGateMix {
    static constexpr bool PERM = false, AFTER_DRAIN = false;
    const bf16_t* BV; bf16_t* MIX;
    __device__ __forceinline__ void operator()(const f32x4 (&acc)[2][2][4][2], const Unit& u, int wr, int wc, int fr, int fq) const {
        typedef unsigned u32x2 __attribute__((ext_vector_type(2)));
        const int row0 = u.pm * BM + wr * 64 + fr, ncol = u.pn * 64 + wc * 16 + 4 * fq;
#pragma unroll
        for (int ai = 0; ai < 2; ++ai)
#pragma unroll
            for (int m = 0; m < 4; ++m) { const size_t row = (size_t)(row0 + ai * HALF + m * 16);
                f32x4 sum = (f32x4){0.f, 0.f, 0.f, 0.f};
#pragma unroll
                for (int i = 0; i < 4; ++i) { const f32x4 gte = acc[ai][i >> 1][m][i & 1];
                    const u32x2 raw = *(const u32x2*)(BV + row * 4096 + i * 1024 + ncol);
                    f32x4 bv; bv[0] = __uint_as_float(raw.x << 16); bv[1] = __uint_as_float(raw.x & 0xffff0000u); bv[2] = __uint_as_float(raw.y << 16); bv[3] = __uint_as_float(raw.y & 0xffff0000u);
#pragma unroll
                    for (int e = 0; e < 4; ++e) { const float sg = __builtin_amdgcn_rcpf(1.0f + __builtin_amdgcn_exp2f(-1.4426950408889634f * gte[e])); sum[e] += sg * bv[e]; } }
                u32x2 w; w.x = cvt_pk_bf16(sum[0], sum[1]); w.y = cvt_pk_bf16(sum[2], sum[3]);
                *(u32x2*)(MIX + row * 1024 + ncol) = w; }
    }
};

template <class Epi, class Sched, bool ALIGN_EPI = false, bool SP2 = false>
__device__ __forceinline__ void gemm_phase(PG8_LAS unsigned char* lds, const Gemm g, const Sched& S, const Epi& E) {
    int tid_ = threadIdx.x; asm volatile("" : "+v"(tid_));
    const int tid = tid_, wid = __builtin_amdgcn_readfirstlane(tid >> 6), lane = tid & 63, wr = wid >> 2, wc = wid & 3, fr = lane & 15, fq = lane >> 4;
    const int K = g.K, nt = K / BK;
    unsigned voffA[2], voffB[2];
#pragma unroll
    for (int i = 0; i < 2; ++i) { int R, C; stage_rc(tid * 16 + i * 8192, R, C); const int Rb = Epi::PERM ? ((R & ~31) + perm32(R & 31)) : R;
        voffA[i] = (unsigned)(R * g.lda + C) * 2u; voffB[i] = (unsigned)(Rb * K + C) * 2u; }
    const size_t kstep = (size_t)(BK * 2);
    const size_t hstepA = (size_t)HALF * g.lda * 2, hstepB = (size_t)HALF * K * 2;
    const size_t tstepA = 2 * hstepA, tstepB = 2 * hstepB;
#define PG8_AOFF(u) ((size_t)(u).pm * tstepA + (g.a_sh >= 0 ? (size_t)((u).pn >> g.a_sh) * (size_t)K * 2 : (size_t)0))
    const unsigned ldsw = (unsigned)wid * 1024u;
    const int aoff = lds_byte(wr * 64 + fr, fq * 8), boff = lds_byte(wc * 32 + fr, fq * 8);
#define PG8_SA(b, h) (((b) * 2 + (h)) * HTB)
#define PG8_SB(b, h) ((4 + (b) * 2 + (h)) * HTB)
#define PG8_STAGE(bufoff, gbase, voff) do { _Pragma("unroll") for (int _i = 0; _i < 2; ++_i) \
        __builtin_amdgcn_global_load_lds((const unsigned*)((const char*)(gbase) + (voff)[_i]), (PG8_LAS unsigned*)(lds + (bufoff) + ldsw + _i * 8192), 16, 0, 0); } while (0)
#define PG8_LDA(dst, b, h) do { _Pragma("unroll") for (int m = 0; m < 4; ++m) _Pragma("unroll") for (int k = 0; k < 2; ++k) dst[m][k] = *(const PG8_LAS bf16x8*)(lds + PG8_SA(b, h) + aoff + m * 2048 + k * 1024); } while (0)
#define PG8_LDB(dst, b, h) do { _Pragma("unroll") for (int n = 0; n < 2; ++n) _Pragma("unroll") for (int k = 0; k < 2; ++k) dst[n][k] = *(const PG8_LAS bf16x8*)(lds + PG8_SB(b, h) + boff + n * 2048 + k * 1024); } while (0)
#define PG8_MMA(ai, bj, At, Bt) do { __builtin_amdgcn_s_setprio(1); _Pragma("unroll") for (int m = 0; m < 4; ++m) _Pragma("unroll") for (int n = 0; n < 2; ++n) _Pragma("unroll") for (int k = 0; k < 2; ++k) \
        acc[ai][bj][m][n] = __builtin_amdgcn_mfma_f32_16x16x32_bf16(Bt[n][k], At[m][k], acc[ai][bj][m][n], 0, 0, 0); __builtin_amdgcn_s_setprio(0); } while (0)
#define PG8_WAIT_V(n) asm volatile("s_waitcnt vmcnt(" #n ")" ::: "memory")
#define PG8_WAIT_L(n) asm volatile("s_waitcnt lgkmcnt(" #n ")" ::: "memory")
#define PG8_BAR __builtin_amdgcn_s_barrier()
#define PG8_SCHED __builtin_amdgcn_sched_barrier(0)
    Unit cur, nxt; int ui = 0;
    if (!S.next(0, cur)) return;
    f32x4 acc[2][2][4][2];
#pragma unroll
    for (int a = 0; a < 2; ++a)
#pragma unroll
        for (int b = 0; b < 2; ++b)
#pragma unroll
            for (int m = 0; m < 4; ++m)
#pragma unroll
                for (int n = 0; n < 2; ++n) acc[a][b][m][n] = (f32x4){0.f, 0.f, 0.f, 0.f};
    bf16x8 At[4][2], B0[2][2], B1[2][2];
    const char* cA = (const char*)g.A + PG8_AOFF(cur); const char* cB = (const char*)g.Bt + (size_t)cur.pn * tstepB;
    S.a_ready(cur);
    if constexpr (SP2) {
        PG8_STAGE(PG8_SB(0, 0), cB, voffB); PG8_STAGE(PG8_SB(0, 1), cB + hstepB, voffB); PG8_STAGE(PG8_SA(0, 0), cA, voffA); PG8_STAGE(PG8_SA(0, 1), cA + hstepA, voffA);
        if (wr == 1) PG8_BAR;
        PG8_WAIT_V(2); PG8_BAR;
        PG8_STAGE(PG8_SB(1, 0), cB + kstep, voffB); PG8_STAGE(PG8_SA(1, 0), cA + kstep, voffA); PG8_STAGE(PG8_SB(1, 1), cB + hstepB + kstep, voffB);
        PG8_WAIT_V(6); PG8_BAR;
    } else {
        PG8_STAGE(PG8_SB(0, 0), cB, voffB); PG8_STAGE(PG8_SA(0, 0), cA, voffA); PG8_STAGE(PG8_SB(0, 1), cB + hstepB, voffB); PG8_STAGE(PG8_SA(0, 1), cA + hstepA, voffA);
        if (wr == 1) PG8_BAR;
        PG8_WAIT_V(4); PG8_BAR;
        PG8_STAGE(PG8_SB(1, 0), cB + kstep, voffB); PG8_STAGE(PG8_SA(1, 0), cA + kstep, voffA); PG8_STAGE(PG8_SB(1, 1), cB + hstepB + kstep, voffB);
        PG8_WAIT_V(6); PG8_BAR;
    }
    for (;;) {
        const bool has_next = S.next(ui + 1, nxt);
        const char* nA = has_next ? (const char*)g.A + PG8_AOFF(nxt) : cA; const char* nB = has_next ? (const char*)g.Bt + (size_t)nxt.pn * tstepB : cB;
        for (int t = 0; t < nt; t += 2) {
            const bool last = (t == nt - 2);
            const char* a1 = cA + (size_t)(t + 1) * kstep;
            const char* a2 = last ? nA : cA + (size_t)(t + 2) * kstep; const char* b2 = last ? nB : cB + (size_t)(t + 2) * kstep;
            const char* a3 = a2 + kstep; const char* b3 = b2 + kstep;
            if (last && has_next) S.a_ready(nxt);
            if constexpr (SP2) {
            PG8_LDB(B0, 0, 0); PG8_LDB(B1, 0, 1); PG8_SCHED; PG8_LDA(At, 0, 0); PG8_STAGE(PG8_SA(1, 1), a1 + hstepA, voffA);
            PG8_WAIT_V(8); PG8_WAIT_L(0); PG8_BAR; PG8_MMA(0, 0, At, B0); PG8_MMA(0, 1, At, B1); PG8_BAR; PG8_SCHED;
            PG8_LDA(At, 0, 1); PG8_STAGE(PG8_SB(0, 0), b2, voffB); PG8_STAGE(PG8_SB(0, 1), b2 + hstepB, voffB); PG8_STAGE(PG8_SA(0, 0), a2, voffA);
            PG8_WAIT_V(8); PG8_WAIT_L(0); PG8_BAR; PG8_MMA(1, 0, At, B0); PG8_MMA(1, 1, At, B1); PG8_BAR; PG8_SCHED;
            PG8_LDB(B0, 1, 0); PG8_LDB(B1, 1, 1); PG8_SCHED; PG8_LDA(At, 1, 0); PG8_STAGE(PG8_SA(0, 1), a2 + hstepA, voffA);
            PG8_WAIT_V(8); PG8_WAIT_L(0); PG8_BAR; PG8_MMA(0, 0, At, B0); PG8_MMA(0, 1, At, B1); PG8_BAR; PG8_SCHED;
            PG8_LDA(At, 1, 1); PG8_STAGE(PG8_SB(1, 0), b3, voffB); PG8_STAGE(PG8_SB(1, 1), b3 + hstepB, voffB); PG8_STAGE(PG8_SA(1, 0), a3, voffA);
            PG8_WAIT_V(8); PG8_WAIT_L(0); PG8_BAR; PG8_MMA(1, 0, At, B0); PG8_MMA(1, 1, At, B1); PG8_BAR; PG8_SCHED;
            } else {
            PG8_LDB(B0, 0, 0); PG8_SCHED; PG8_LDA(At, 0, 0); PG8_STAGE(PG8_SA(1, 1), a1 + hstepA, voffA);
            PG8_WAIT_L(8); PG8_BAR; PG8_WAIT_L(0); PG8_MMA(0, 0, At, B0); PG8_BAR; PG8_SCHED;
            PG8_LDB(B1, 0, 1); PG8_STAGE(PG8_SB(0, 0), b2, voffB);
            PG8_BAR; PG8_WAIT_L(0); PG8_MMA(0, 1, At, B1); PG8_BAR;
            PG8_LDA(At, 0, 1); PG8_STAGE(PG8_SA(0, 0), a2, voffA);
            PG8_BAR; PG8_WAIT_L(0); PG8_MMA(1, 0, At, B0); PG8_BAR; PG8_SCHED;
            PG8_STAGE(PG8_SB(0, 1), b2 + hstepB, voffB);
            PG8_WAIT_V(6); PG8_BAR; PG8_MMA(1, 1, At, B1); PG8_BAR;
            PG8_LDB(B0, 1, 0); PG8_SCHED; PG8_LDA(At, 1, 0); PG8_STAGE(PG8_SA(0, 1), a2 + hstepA, voffA);
            PG8_WAIT_L(8); PG8_BAR; PG8_WAIT_L(0); PG8_MMA(0, 0, At, B0); PG8_BAR; PG8_SCHED;
            PG8_LDB(B1, 1, 1); PG8_STAGE(PG8_SB(1, 0), b3, voffB);
            PG8_BAR; PG8_WAIT_L(0); PG8_MMA(0, 1, At, B1); PG8_BAR;
            PG8_LDA(At, 1, 1); PG8_STAGE(PG8_SA(1, 0), a3, voffA);
            PG8_BAR; PG8_WAIT_L(0); PG8_MMA(1, 0, At, B0); PG8_BAR; PG8_SCHED;
            PG8_STAGE(PG8_SB(1, 1), b3 + hstepB, voffB);
            PG8_WAIT_V(6); PG8_BAR; PG8_MMA(1, 1, At, B1); PG8_BAR;
            }
        }
        if constexpr (ALIGN_EPI) { if (wr == 0) PG8_BAR; }
        if constexpr (!Epi::AFTER_DRAIN) { E(acc, cur, wr, wc, fr, fq); S.done(cur); }
        if (!has_next) break;
#pragma unroll
        for (int a = 0; a < 2; ++a)
#pragma unroll
            for (int b = 0; b < 2; ++b)
#pragma unroll
                for (int m = 0; m < 4; ++m)
#pragma unroll
                    for (int n = 0; n < 2; ++n) acc[a][b][m][n] = (f32x4){0.f, 0.f, 0.f, 0.f};
        cur = nxt; cA = nA; cB = nB; ++ui;
        if constexpr (ALIGN_EPI) { if (wr == 1) PG8_BAR; }
    }
    PG8_WAIT_V(0);
    if constexpr (!ALIGN_EPI) { if (wr == 0) PG8_BAR; }
    PG8_BAR;
    if constexpr (Epi::AFTER_DRAIN) { E.fused(acc, cur, wr, wc, fr, fq, lds, wid, lane); S.done(cur); }
#undef PG8_AOFF
#undef PG8_SA
#undef PG8_SB
#undef PG8_STAGE
#undef PG8_LDA
#undef PG8_LDB
#undef PG8_MMA
#undef PG8_WAIT_V
#undef PG8_WAIT_L
#undef PG8_BAR
#undef PG8_SCHED
}
}

#define GAS __attribute__((address_space(1)))
#define LAS __attribute__((address_space(3)))
typedef unsigned short bf16;
typedef unsigned v4u __attribute__((ext_vector_type(4)));
typedef float f32x4 __attribute__((ext_vector_type(4)));
typedef short bf16x8 __attribute__((ext_vector_type(8)));
typedef GAS unsigned gu32;
typedef GAS unsigned long long gu64;
#define RLX_AGENT __ATOMIC_RELAXED, __HIP_MEMORY_SCOPE_AGENT
#define LDS_WAIT() asm volatile("s_waitcnt lgkmcnt(0)" ::: "memory")
#define VM_WAIT() asm volatile("s_waitcnt vmcnt(0)" ::: "memory")
__device__ __forceinline__ unsigned long long rt() { return __builtin_amdgcn_s_memrealtime(); }
__device__ __forceinline__ unsigned f2bf(float f) { unsigned u = __builtin_bit_cast(unsigned, f); return (u + 0x7fffu + ((u >> 16) & 1u)) >> 16; }
__device__ __forceinline__ unsigned pk2(float lo, float hi) { return f2bf(lo) | (f2bf(hi) << 16); }

#define XB_TMO      128
#define XB_XCNT(j)  (256  + 64 * (j))
#define XB_XSUB(j)  (1280 + 64 * (j))
#define XB_XGEN(j)  (2304 + 64 * (j))
#define XB_TOP      3328
#define XB_TOPGEN   3392
#define XCD_BAR_WORDS 3456
#define XB_SPIN_CAP (1u << 18)

__device__ __forceinline__ unsigned xb_ld(unsigned* p)              { return __hip_atomic_load(p, __ATOMIC_RELAXED, __HIP_MEMORY_SCOPE_AGENT); }
__device__ __forceinline__ unsigned xb_add(unsigned* p, unsigned v) { return __hip_atomic_fetch_add(p, v, __ATOMIC_RELAXED, __HIP_MEMORY_SCOPE_AGENT); }
__device__ __forceinline__ unsigned xb_xcc_id() { return (unsigned)__builtin_amdgcn_s_getreg((3 << 11) | 20) & 0xFu; }
#define XB_SPIN(cond, bar) do { unsigned _sp = 0; while (cond) { __builtin_amdgcn_s_sleep(1); \
    if ((++_sp & 255u) == 0u) { if (xb_ld(&(bar)[XB_TMO])) break; if (_sp > XB_SPIN_CAP) { atomicAdd(&(bar)[XB_TMO], 1u); break; } } } } while (0)

struct XcdBarrier {
    unsigned* bar; unsigned x;
    volatile LAS unsigned* st;
};

__device__ __forceinline__ XcdBarrier xcd_barrier_post(unsigned* bar, volatile LAS unsigned* st) {
    XcdBarrier b; b.bar = bar; b.x = xb_xcc_id(); b.st = st;
    if (threadIdx.x == 0) (void)xb_add(&bar[XB_XCNT(b.x)], 1u);
    return b;
}
__device__ __forceinline__ void xcd_barrier_complete(unsigned* bar, unsigned x, unsigned& nloc, unsigned& nx) {
    const unsigned G = gridDim.x * gridDim.y * gridDim.z;
    unsigned sum, cnt, mine, sp = 0u;
    for (;;) {
        sum = 0u; cnt = 0u; mine = 0u;
#pragma unroll
        for (unsigned j = 0; j < 16; ++j) { const unsigned c = xb_ld(&bar[XB_XCNT(j)]); sum += c; cnt += (c > 0u) ? 1u : 0u; mine = (j == x) ? c : mine; }
        if (sum == G) break;
        __builtin_amdgcn_s_sleep(1);
        if ((++sp & 255u) == 0u) { if (xb_ld(&bar[XB_TMO])) break; if (sp > XB_SPIN_CAP) { atomicAdd(&bar[XB_TMO], 1u); break; } }
    }
    nloc = mine > 0u ? mine : 1u; nx = cnt > 0u ? cnt : 1u;
}

__device__ __forceinline__ void xcd_barrier(const XcdBarrier& b) {
    asm volatile("s_waitcnt vmcnt(0)" ::: "memory");
    __syncthreads();
    if (threadIdx.x == 0) {
        unsigned* bar = b.bar;
        __builtin_amdgcn_s_waitcnt(0);
        unsigned nloc = b.st[0], nx = b.st[1];
        if (nloc == 0u) { xcd_barrier_complete(bar, b.x, nloc, nx); b.st[0] = nloc; b.st[1] = nx; }
        const unsigned old = xb_add(&bar[XB_XSUB(b.x)], 1u);
        const unsigned gen = old / nloc;
        if (old + 1u == (gen + 1u) * nloc) {
            __builtin_amdgcn_fence(__ATOMIC_RELEASE, "agent");
            asm volatile("s_waitcnt vmcnt(0)" ::: "memory");
            const unsigned og = xb_add(&bar[XB_TOP], 1u);
            const unsigned tg = og / nx;
            if (og + 1u == (tg + 1u) * nx) xb_add(&bar[XB_TOPGEN], 1u);
            else XB_SPIN(xb_ld(&bar[XB_TOPGEN]) == tg, bar);
            __builtin_amdgcn_fence(__ATOMIC_ACQUIRE, "agent");
            xb_add(&bar[XB_XGEN(b.x)], 1u);
            asm volatile("s_waitcnt vmcnt(0)" ::: "memory");
        } else {
            XB_SPIN(xb_ld(&bar[XB_XGEN(b.x)]) == gen, bar);
            __builtin_amdgcn_fence(__ATOMIC_ACQUIRE, "agent");
            asm volatile("s_waitcnt vmcnt(0)" ::: "memory");
        }
    }
    __syncthreads();
}

constexpr int NWAVES = 8;
constexpr int NB = 16, SEQ = 2048, DM = 1024, MTOK = NB * SEQ, DEPTH = 4;
constexpr int P_IN = 2988, NPROJ = 3072, DFF = 2816, NUP = 2 * DFF, CHROWS = MTOK / 2;
constexpr float RMS_EPS = 1e-6f;
#ifndef MK_N_LAUNCHES
#define MK_N_LAUNCHES 1
#endif
constexpr int NP = 13;
constexpr int NPH = DEPTH * NP + 1;

constexpr size_t MiB = 1u << 20;
constexpr size_t WS_CTL = 0, CTL_ZERO_BYTES = 1 * MiB;
constexpr size_t WS_WIN = 1 * MiB, WS_WG = 7 * MiB, WS_WB = 15 * MiB, WS_WO = 17 * MiB, WS_WUP = 19 * MiB, WS_WD = 30 * MiB;
constexpr size_t WS_MASK = 36 * MiB;
constexpr size_t WS_CUM = 44 * MiB;
constexpr size_t WS_KMEAN = 45 * MiB;
constexpr size_t WS_XN = 48 * MiB;
constexpr size_t WS_PQ = 112 * MiB, WS_PK = 176 * MiB, WS_PV = 240 * MiB;
constexpr size_t WS_MIX = 432 * MiB;
constexpr size_t WS_BV = 176 * MiB;
constexpr size_t WS_HDN = 112 * MiB;
constexpr size_t WS_ACT = 288 * MiB;
constexpr size_t WS_END = 496 * MiB;
static_assert(WS_BV + (size_t)MTOK * 4096 * 2 <= WS_MIX && WS_HDN + (size_t)CHROWS * NUP * 2 <= WS_ACT && WS_ACT + (size_t)MTOK * DFF * 2 <= WS_END && WS_MIX + (size_t)MTOK * 1024 * 2 <= WS_END, "ws map");
constexpr int CW_TMO = 0, CW_CODE = 1, CW_BAR = 4096;

constexpr int RING_OFF = 0, RING_BYTES = 131072;
constexpr int AUX_OFF = 131072;
constexpr int AUXW_OFF = AUX_OFF + 16384;
constexpr int LUT_OFF = AUXW_OFF + 512, LUT_STRIDE = 132;
constexpr int LDSCTL_OFF = LUT_OFF + 8 * LUT_STRIDE * 4, MISC_OFF = LDSCTL_OFF + 64;
constexpr int LDS_BYTES = 155648;
static_assert(MISC_OFF + 128 <= LDS_BYTES, "LDS map");

struct Args { const float* in[14]; float* out; unsigned char* ws; int g_lo, g_hi, li, pad; };
struct Frame {
    LAS unsigned char* lds;
    volatile LAS unsigned* MISC;
    unsigned char* ws;
    int tid, lane, wave;
    int vcu, G;
};
typedef __attribute__((address_space(4))) const Args CArgs;
__device__ __forceinline__ const float* inp(int i) { CArgs* p = (CArgs*)__builtin_amdgcn_kernarg_segment_ptr(); asm volatile("" : "+s"(p)); return p->in[i]; }
__device__ __forceinline__ float* outp() { CArgs* p = (CArgs*)__builtin_amdgcn_kernarg_segment_ptr(); asm volatile("" : "+s"(p)); return p->out; }
#define F_CTL ((gu32*)(F.ws + WS_CTL))
#define F_WinT ((bf16*)(F.ws + WS_WIN))
#define F_WgT ((bf16*)(F.ws + WS_WG))
#define F_WbT ((bf16*)(F.ws + WS_WB))
#define F_WoT ((bf16*)(F.ws + WS_WO))
#define F_WupT ((bf16*)(F.ws + WS_WUP))
#define F_WdT ((bf16*)(F.ws + WS_WD))
#define F_XN ((bf16*)(F.ws + WS_XN))
#define F_PQ ((bf16*)(F.ws + WS_PQ))
#define F_PK ((bf16*)(F.ws + WS_PK))
#define F_PV ((bf16*)(F.ws + WS_PV))
#define F_MIX ((bf16*)(F.ws + WS_MIX))
#define F_BV ((bf16*)(F.ws + WS_BV))
#define F_HDN ((bf16*)(F.ws + WS_HDN))
#define F_ACT ((bf16*)(F.ws + WS_ACT))
#define F_MASK ((unsigned long long*)(F.ws + WS_MASK))
#define F_CUM ((float*)(F.ws + WS_CUM))
#define F_KMEAN ((float*)(F.ws + WS_KMEAN))
__device__ __forceinline__ float wave_sum(float v) {
#pragma unroll
    for (int o = 1; o < 64; o <<= 1) v += __shfl_xor(v, o);
    return v;
}
__device__ __forceinline__ float bf2f(unsigned short b) { return __uint_as_float((unsigned)b << 16); }
__device__ __forceinline__ float bflo(unsigned w) { return __uint_as_float(w << 16); }
__device__ __forceinline__ float bfhi(unsigned w) { return __uint_as_float(w & 0xffff0000u); }
template <class T> __device__ __forceinline__ T* vptr(T* p) { asm volatile("" : "+v"(p)); return p; }

__device__ __forceinline__ long proj_src_col(int n) {
    const int t = n >> 10, c = n & 1023;
    if (t == 0) { const int s = c >> 8, r = c & 255; return (s == 0 ? 0 : s == 1 ? 768 : s == 2 ? 1536 : 2308) + r; }
    if (t == 2) { const int s = c >> 8, r = c & 255; return (s == 0 ? 512 : s == 1 ? 1280 : s == 2 ? 2048 : 2692) + r; }
    if (c < 768) { const int s = c >> 8, r = c & 255; return (s == 0 ? 256 : s == 1 ? 1024 : 1792) + r; }
    if (c < 832) return 2564 + (c - 768);
    if (c < 896) return 2628 + (c - 832);
    if (c < 928) return 2948 + (c - 896);
    if (c < 936) return 2980 + (c - 928);
    if (c < 940) return 2304 + (c - 936);
    return -1;
}
struct MapProj { __device__ __forceinline__ long operator()(int n) const { return proj_src_col(n); } };
struct MapId { __device__ __forceinline__ long operator()(int n) const { return n; } };
struct MapGate { __device__ __forceinline__ long operator()(int R) const { const int pn = R >> 8, c = R & 255, bj = c >> 7, wc = (c >> 5) & 3, nn = (c >> 4) & 1, fq = (c >> 2) & 3, e = c & 3;
    return (long)(2 * bj + nn) * (1024L * 1024L) + 64 * pn + 16 * wc + 4 * fq + e; } };
struct MapBranch { __device__ __forceinline__ long operator()(int R) const { return (long)(R >> 10) * (256L * 1024L) + (R & 1023); } };
template <class Map> __device__ __forceinline__ void tr_item(const float* W, int K, int Nsrc, bf16* WT, const Map& map, LAS float* scr, int item, int nblk, int lane) {
    const int kb = item / nblk, nb = item % nblk, k0 = 64 * kb, n0 = 32 * nb;
    const long so = map(n0 + (lane & 31));
#pragma unroll 8
    for (int i = 0; i < 32; ++i) { const int kk = 2 * i + (lane >> 5); scr[kk * 33 + (lane & 31)] = so >= 0 ? W[(size_t)so + (size_t)(k0 + kk) * Nsrc] : 0.f; }
    LDS_WAIT(); asm volatile("" ::: "memory");
    const int c = lane & 7;
#pragma unroll
    for (int j = 0; j < 4; ++j) { const int n = (lane >> 3) + 8 * j; const LAS float* s = scr + (8 * c) * 33 + n;
        v4u o; o.x = pk2(s[0 * 33], s[1 * 33]); o.y = pk2(s[2 * 33], s[3 * 33]); o.z = pk2(s[4 * 33], s[5 * 33]); o.w = pk2(s[6 * 33], s[7 * 33]);
        *(GAS v4u*)(WT + (size_t)(n0 + n) * K + k0 + 8 * c) = o; }
    LDS_WAIT(); asm volatile("" ::: "memory");
}
__device__ __forceinline__ void rms_row(const float* xrow, const float* g, bf16* orow, float* copy_dst, int lane) {
    const GAS f32x4* xr = (const GAS f32x4*)xrow + lane; const GAS f32x4* gr = (const GAS f32x4*)g + lane;
    f32x4 v[4]; float s = 0.f;
#pragma unroll
    for (int j = 0; j < 4; ++j) { v[j] = xr[64 * j]; s += (v[j].x * v[j].x + v[j].y * v[j].y) + (v[j].z * v[j].z + v[j].w * v[j].w); }
    const float rstd = 1.0f / sqrtf(wave_sum(s) * (1.f / DM) + RMS_EPS);
    GAS unsigned long long* o8 = (GAS unsigned long long*)orow + lane;
#pragma unroll
    for (int j = 0; j < 4; ++j) { const f32x4 gg = gr[64 * j]; const f32x4 y = v[j] * rstd * gg;
        o8[64 * j] = (unsigned long long)pk2(y.x, y.y) | ((unsigned long long)pk2(y.z, y.w) << 32);
        if (copy_dst) ((GAS f32x4*)copy_dst)[lane + 64 * j] = v[j]; }
}
__device__ __forceinline__ void p_wconv_rms(Frame& F, int l, const float* xsrc, float* copy_dst, const float* gain) {
    LAS float* scr = (LAS float*)(F.lds + RING_OFF + F.wave * 16384);
    const int gw = F.vcu * NWAVES + F.wave, NGW = F.G * NWAVES;
    constexpr int I_WIN = 16 * 96, I_WG = 16 * 128, I_WB = 4 * 128, I_WO = 16 * 32, I_WUP = 16 * 176, I_WD = 44 * 32;
    constexpr int NITEMS = I_WIN + I_WG + I_WB + I_WO + I_WUP + I_WD;
    const float* w_in = inp(4) + (size_t)l * DM * P_IN; const float* w_gate = inp(7) + (size_t)l * 4 * DM * DM; const float* w_branch = inp(8) + (size_t)l * 4 * 256 * DM;
    const float* w_out = inp(9) + (size_t)l * DM * DM; const float* w_up = inp(10) + (size_t)l * DM * NUP; const float* w_down = inp(13) + (size_t)l * DFF * DM;
    for (int it = gw; it < NITEMS; it += NGW) {
        int r = it;
        if (r < I_WIN) { tr_item(w_in, DM, P_IN, F_WinT, MapProj(), scr, r, 96, F.lane); continue; } r -= I_WIN;
        if (r < I_WG) { tr_item(w_gate, DM, DM, F_WgT, MapGate(), scr, r, 128, F.lane); continue; } r -= I_WG;
        if (r < I_WB) { tr_item(w_branch, 256, DM, F_WbT, MapBranch(), scr, r, 128, F.lane); continue; } r -= I_WB;
        if (r < I_WO) { tr_item(w_out, DM, DM, F_WoT, MapId(), scr, r, 32, F.lane); continue; } r -= I_WO;
        if (r < I_WUP) { tr_item(w_up, DM, NUP, F_WupT, MapId(), scr, r, 176, F.lane); continue; } r -= I_WUP;
        tr_item(w_down, DFF, DM, F_WdT, MapId(), scr, r, 32, F.lane);
    }
    for (int m = gw; m < MTOK; m += NGW) rms_row(xsrc + (size_t)m * DM, gain, F_XN + (size_t)m * DM, copy_dst ? copy_dst + (size_t)m * DM : nullptr, F.lane);
}
__device__ __forceinline__ void p_rms(Frame& F, const float* xsrc, const float* gain) {
    const int gw = F.vcu * NWAVES + F.wave, NGW = F.G * NWAVES;
    for (int m = gw; m < MTOK; m += NGW) rms_row(xsrc + (size_t)m * DM, gain, F_XN + (size_t)m * DM, nullptr, F.lane);
}
__device__ __forceinline__ void p_final(Frame& F, float* x, const float* gain) {
    const int gw = F.vcu * NWAVES + F.wave, NGW = F.G * NWAVES;
    for (int m = gw; m < MTOK; m += NGW) {
        GAS f32x4* xr = (GAS f32x4*)(x + (size_t)m * DM) + F.lane; const GAS f32x4* gr = (const GAS f32x4*)gain + F.lane;
        f32x4 v[4]; float s = 0.f;
#pragma unroll
        for (int j = 0; j < 4; ++j) { v[j] = xr[64 * j]; s += (v[j].x * v[j].x + v[j].y * v[j].y) + (v[j].z * v[j].z + v[j].w * v[j].w); }
        const float rstd = 1.0f / sqrtf(wave_sum(s) * (1.f / DM) + RMS_EPS);
#pragma unroll
        for (int j = 0; j < 4; ++j) xr[64 * j] = v[j] * rstd * gr[64 * j];
    }
}

__device__ __forceinline__ void idx_unit(Frame& F, int u) {
    const int tid = F.tid, lane = F.lane;
    const int b = u >> 7, t0 = (u & 127) * 16;
    LAS float* isc = (LAS float*)(F.lds + RING_OFF);
    LAS float* qs = (LAS float*)(F.lds + AUX_OFF);
    LAS float* wq = (LAS float*)(F.lds + AUXW_OFF);
    {   const int r = tid >> 5, c = (tid & 31) * 8;
        const v4u raw = *(const GAS v4u*)(F_PV + ((size_t)b * SEQ + t0 + r) * 1024 + 768 + c);
        LAS float* d = qs + r * 256 + c;
        d[0] = bflo(raw.x); d[1] = bfhi(raw.x); d[2] = bflo(raw.y); d[3] = bfhi(raw.y); d[4] = bflo(raw.z); d[5] = bfhi(raw.z); d[6] = bflo(raw.w); d[7] = bfhi(raw.w);
        if (tid < 128) wq[tid] = bf2f(*(const GAS unsigned short*)(F_PK + ((size_t)b * SEQ + t0 + (tid >> 3)) * 1024 + 928 + (tid & 7)));
    }
    __syncthreads();
    const int smax = t0 + 15;
    for (int s = tid; s <= smax; s += 512) {
        float kd[32];
        const GAS v4u* kp = (const GAS v4u*)(F_PK + ((size_t)b * SEQ + s) * 1024 + 896);
#pragma unroll
        for (int i = 0; i < 4; ++i) { const v4u raw = kp[i]; kd[8 * i + 0] = bflo(raw.x); kd[8 * i + 1] = bfhi(raw.x); kd[8 * i + 2] = bflo(raw.y); kd[8 * i + 3] = bfhi(raw.y);
            kd[8 * i + 4] = bflo(raw.z); kd[8 * i + 5] = bfhi(raw.z); kd[8 * i + 6] = bflo(raw.w); kd[8 * i + 7] = bfhi(raw.w); }
#pragma unroll 1
        for (int q = 0; q < 16; ++q) {
            float acc = 0.f;
#pragma unroll
            for (int h = 0; h < 8; ++h) { float d = 0.f;
#pragma unroll
                for (int dd = 0; dd < 32; dd += 4) { const f32x4 qq = *(const LAS f32x4*)(qs + q * 256 + h * 32 + dd); d += qq.x * kd[dd] + qq.y * kd[dd + 1] + qq.z * kd[dd + 2] + qq.w * kd[dd + 3]; }
                acc += wq[q * 8 + h] * fmaxf(d, 0.f); }
            isc[q * 2048 + s] = acc;
        }
    }
    __syncthreads();
#pragma unroll 1
    for (int qq = 0; qq < 2; ++qq) {
        const int q = 2 * F.wave + qq, t = t0 + q;
        GAS unsigned long long* mrow = (GAS unsigned long long*)F_MASK + ((size_t)b * SEQ + t) * 32;
        unsigned long long mine = 0ull;
        if (t < 256) {
            const int lo = 64 * lane;
            if (t >= lo + 63) mine = ~0ull; else if (t >= lo) mine = (2ull << (t - lo)) - 1ull;
        } else {
            unsigned uk[32];
#pragma unroll
            for (int j = 0; j < 32; ++j) { const int key = lane + 64 * j; const unsigned bits = __float_as_uint(isc[q * 2048 + key]);
                unsigned uu = (bits & 0x80000000u) ? ~bits : (bits | 0x80000000u); if (key > t) uu = 0u; uk[j] = uu; }
            unsigned T = 0u;
#pragma unroll 1
            for (int bit = 31; bit >= 0; --bit) { const unsigned cand = T | (1u << bit); int c = 0;
#pragma unroll
                for (int j = 0; j < 32; ++j) c += __popcll(__ballot(uk[j] >= cand));
                if (c >= 256) T = cand; }
            int cgt = 0;
#pragma unroll
            for (int j = 0; j < 32; ++j) cgt += __popcll(__ballot(uk[j] > T));
            const int need = 256 - cgt; int run = 0;
#pragma unroll
            for (int j = 0; j < 32; ++j) {
                unsigned long long sel = __ballot(uk[j] > T); unsigned long long eq = __ballot(uk[j] == T);
                if (eq != 0ull && run < need) { const int avail = need - run, pe = __popcll(eq);
                    if (pe <= avail) { sel |= eq; run += pe; }
                    else { unsigned long long e = eq, take = 0ull; for (int k = 0; k < avail; ++k) { const unsigned long long low = e & (0ull - e); take |= low; e ^= low; } sel |= take; run += avail; } }
                if (lane == j) mine = sel;
            }
        }
        if (lane < 32) mrow[lane] = mine;
    }
    __syncthreads();
}
__device__ __forceinline__ void p_prep(Frame& F, int l) {
    for (int u = blockIdx.x; u < MTOK / 16; u += F.G) idx_unit(F, u);
    const int gw = F.vcu * NWAVES + F.wave, NGW = F.G * NWAVES, lane = F.lane;
    for (int it = gw; it < NB * 4; it += NGW) {
        const int b = it >> 2, h = it & 3; const float bfv = inp(5)[l * 4 + h];
        float v[32]; float run = 0.f;
#pragma unroll
        for (int i = 0; i < 32; ++i) { const float x = bf2f(*(const GAS unsigned short*)(F_PK + ((size_t)b * SEQ + lane * 32 + i) * 1024 + 936 + h)) + bfv;
            run += fminf(x, 0.f) - log1pf(expf(-fabsf(x))); v[i] = run; }
        float incl = run;
#pragma unroll
        for (int o = 1; o < 64; o <<= 1) { const float n = __shfl_up(incl, o); if (lane >= o) incl += n; }
        const float off = incl - run;
        GAS float* cp = (GAS float*)F_CUM + (size_t)it * SEQ + lane * 32;
#pragma unroll
        for (int i = 0; i < 32; ++i) cp[i] = v[i] + off;
    }
    for (int it = gw; it < NB * 4 * 8; it += NGW) {
        const int n = it & 7, h = (it >> 3) & 3, b = it >> 5;
        const GAS unsigned short* kp = (const GAS unsigned short*)(F_PK + ((size_t)b * SEQ + n * 256) * 1024 + 256 + h * 64 + lane);
        float s = 0.f;
#pragma unroll 8
        for (int j = 0; j < 256; ++j) s += bf2f(kp[(size_t)j * 1024]);
        ((GAS float*)F_KMEAN)[(size_t)it * 64 + lane] = s * (1.f / 256.f);
    }
}

__device__ __forceinline__ void attn_item(Frame& F, int mode, int b, int h, int qblk) {
    const int lane = F.lane, ql = lane & 31, hf = lane >> 5;
    LAS unsigned char* Ks = F.lds + RING_OFF + F.wave * 16384; LAS unsigned char* Vs = Ks + 8192;
    LAS float* cs = (LAS float*)(F.lds + AUX_OFF + F.wave * 256);
    const LAS float* lut = (const LAS float*)(F.lds + LUT_OFF) + ((mode == 3 ? 4 : 0) + h) * LUT_STRIDE;
    const int t0 = qblk * 32, t = t0 + ql; const size_t rowq = (size_t)b * SEQ + t;
    int qcol; const bf16* Kb; const bf16* Vb;
    if (mode == 0) { qcol = h * 64; Kb = F_PK + h * 64; Vb = F_PV + h * 64; }
    else if (mode == 1) { qcol = 256 + h * 64; Kb = F_PK + 256 + h * 64; Vb = F_PV + 256 + h * 64; }
    else if (mode == 2) { qcol = 512 + h * 64; Kb = F_PK + 512 + h * 64; Vb = F_PV + 512 + h * 64; }
    else { qcol = 768 + h * 64; Kb = F_PK + 768; Vb = F_PK + 832; }
    float qv[32];
    {   const GAS v4u* qp = (const GAS v4u*)(F_PQ + rowq * 1024 + qcol + 32 * hf);
#pragma unroll
        for (int i = 0; i < 4; ++i) { const v4u r = qp[i]; qv[8 * i + 0] = 0.125f * bflo(r.x); qv[8 * i + 1] = 0.125f * bfhi(r.x); qv[8 * i + 2] = 0.125f * bflo(r.y); qv[8 * i + 3] = 0.125f * bfhi(r.y);
            qv[8 * i + 4] = 0.125f * bflo(r.z); qv[8 * i + 5] = 0.125f * bfhi(r.z); qv[8 * i + 6] = 0.125f * bflo(r.w); qv[8 * i + 7] = 0.125f * bfhi(r.w); }
    }
    float o[32];
#pragma unroll
    for (int d = 0; d < 32; ++d) o[d] = 0.f;
    float mx = -1e30f, lsum = 0.f, E = 0.f;
    const int own = qblk >> 3; unsigned selbits = 0u;
    if (mode == 1) {
        float gt[7];
#pragma unroll
        for (int n = 0; n < 7; ++n) { gt[n] = 0.f;
            if (n < own) { const GAS f32x4* kmp = vptr((const GAS f32x4*)((const GAS float*)F_KMEAN + ((size_t)((b * 4 + h) * 8 + n)) * 64)) + 8 * hf; float g = 0.f;
#pragma unroll
                for (int i = 0; i < 8; ++i) { const f32x4 km = kmp[i]; g += qv[4 * i] * km.x + qv[4 * i + 1] * km.y + qv[4 * i + 2] * km.z + qv[4 * i + 3] * km.w; }
                gt[n] = g + __shfl_xor(g, 32); } }
#pragma unroll
        for (int n = 0; n < 7; ++n) if (n < own) { int rank = 0;
#pragma unroll
            for (int m2 = 0; m2 < 7; ++m2) if (m2 != n && m2 < own) rank += ((gt[m2] > gt[n]) || (gt[m2] == gt[n] && m2 < n)) ? 1 : 0;
            if (rank < 3) selbits |= 1u << n; }
    }
    float cq = 0.f;
    if (mode == 2) cq = ((const GAS float*)F_CUM)[(size_t)(b * 4 + h) * SEQ + t];
    const GAS unsigned long long* mrow = (const GAS unsigned long long*)F_MASK + rowq * 32;
    const int nch = (qblk >> 1) + 1;
#pragma unroll 1
    for (int ci = 0; ci < nch; ++ci) {
        const int c = (mode == 0) ? (nch - 1 - ci) : ci; const int nblk = c >> 2;
        if (mode == 1 && nblk != own && __ballot((selbits >> nblk) & 1u) == 0ull) continue;
        asm volatile("s_waitcnt lgkmcnt(0)" ::: "memory");
        const size_t krow0 = (size_t)b * SEQ + 64 * c;
#pragma unroll
        for (int i = 0; i < 8; ++i) { const int r = i * 8 + (lane >> 3), pc = lane & 7;
            const v4u kk = *(const GAS v4u*)(Kb + (krow0 + r) * 1024 + pc * 8); const v4u vv = *(const GAS v4u*)(Vb + (krow0 + r) * 1024 + pc * 8);
            *(LAS v4u*)(Ks + r * 128 + pc * 16) = kk; *(LAS v4u*)(Vs + r * 128 + pc * 16) = vv; }
        if (mode == 2) cs[lane] = ((const GAS float*)F_CUM)[(size_t)(b * 4 + h) * SEQ + 64 * c + lane];
        unsigned long long mb = ~0ull; if (mode == 3) mb = mrow[c];
        asm volatile("s_waitcnt vmcnt(0) lgkmcnt(0)" ::: "memory");
        const bool selblk = (mode != 1) || (nblk == own) || (((selbits >> nblk) & 1u) != 0u);
#pragma unroll 1
        for (int jj = 0; jj < 64; ++jj) {
            const int j = (mode == 0) ? 63 - jj : jj; const int s = 64 * c + j;
            if (s > t0 + 31) continue;
            float dot = 0.f;
#pragma unroll
            for (int i = 0; i < 4; ++i) { const v4u kk = *(const LAS v4u*)(Ks + j * 128 + hf * 64 + i * 16);
                dot += qv[8 * i + 0] * bflo(kk.x) + qv[8 * i + 1] * bfhi(kk.x) + qv[8 * i + 2] * bflo(kk.y) + qv[8 * i + 3] * bfhi(kk.y)
                     + qv[8 * i + 4] * bflo(kk.z) + qv[8 * i + 5] * bfhi(kk.z) + qv[8 * i + 6] * bflo(kk.w) + qv[8 * i + 7] * bfhi(kk.w); }
            dot += __shfl_xor(dot, 32);
            float p;
            if (mode == 0) {
                const bool valid = s < t;
                const float sp = fmaxf(dot, 0.f) + __logf(1.0f + __expf(-fabsf(dot)));
                p = valid ? __expf(dot - sp + E) : 0.f; E += valid ? -sp : 0.f;
            } else {
                const bool valid = (s <= t) && selblk && (((mb >> j) & 1ull) != 0ull);
                float logit = dot;
                if (mode == 2) logit += cq - cs[j];
                if (mode == 1 || mode == 3) { int dist = t - s; dist = dist < 0 ? 0 : (dist > 128 ? 128 : dist); logit += lut[dist]; }
                if (valid && logit > mx + 8.0f) { const float f = __expf(mx - logit); lsum *= f;
#pragma unroll
                    for (int d = 0; d < 32; ++d) o[d] *= f;
                    mx = logit; }
                p = valid ? __expf(logit - mx) : 0.f; lsum += p;
            }
#pragma unroll
            for (int i = 0; i < 4; ++i) { const v4u vv = *(const LAS v4u*)(Vs + j * 128 + hf * 64 + i * 16);
                o[8 * i + 0] += p * bflo(vv.x); o[8 * i + 1] += p * bfhi(vv.x); o[8 * i + 2] += p * bflo(vv.y); o[8 * i + 3] += p * bfhi(vv.y);
                o[8 * i + 4] += p * bflo(vv.z); o[8 * i + 5] += p * bfhi(vv.z); o[8 * i + 6] += p * bflo(vv.w); o[8 * i + 7] += p * bfhi(vv.w); }
        }
    }
    const float inv = (mode == 0) ? 1.0f : 1.0f / lsum;
    GAS v4u* op = (GAS v4u*)(F_PQ + rowq * 1024 + qcol + 32 * hf);
#pragma unroll
    for (int i = 0; i < 4; ++i) { v4u w; w.x = pk2(o[8 * i + 0] * inv, o[8 * i + 1] * inv); w.y = pk2(o[8 * i + 2] * inv, o[8 * i + 3] * inv); w.z = pk2(o[8 * i + 4] * inv, o[8 * i + 5] * inv); w.w = pk2(o[8 * i + 6] * inv, o[8 * i + 7] * inv); op[i] = w; }
}
__device__ __forceinline__ void p_attn(Frame& F) {
    const int gw = F.vcu * NWAVES + F.wave, NGW = F.G * NWAVES;
#pragma unroll 1
    for (int mode = 0; mode < 4; ++mode)
#pragma unroll 1
        for (int r = gw; r < NB * 4 * 64; r += NGW) { const int bh = r >> 6; int qb = r & 63; if (mode & 1) qb = 63 - qb; attn_item(F, mode, bh >> 2, bh & 3, qb); }
}

__device__ __forceinline__ void p_conv(Frame& F, int l, int chunk) {
    const int gw = F.vcu * NWAVES + F.wave, NGW = F.G * NWAVES, lane = F.lane;
    const float* cw = inp(11) + (size_t)l * 3 * NUP; const float* cb = inp(12) + (size_t)l * NUP;
    typedef unsigned u32x2 __attribute__((ext_vector_type(2)));
    for (int it = gw; it < (CHROWS / 32) * 11; it += NGW) {
        const int rr = it / 11, cbk = it % 11, f = cbk * 256 + lane * 4, r0 = rr * 32;
        const f32x4 wg0 = *(const GAS f32x4*)(cw + f), wg1 = *(const GAS f32x4*)(cw + NUP + f), wg2 = *(const GAS f32x4*)(cw + 2 * NUP + f), bg = *(const GAS f32x4*)(cb + f);
        const f32x4 wu0 = *(const GAS f32x4*)(cw + DFF + f), wu1 = *(const GAS f32x4*)(cw + NUP + DFF + f), wu2 = *(const GAS f32x4*)(cw + 2 * NUP + DFF + f), bu = *(const GAS f32x4*)(cb + DFF + f);
        f32x4 g2 = (f32x4){0.f, 0.f, 0.f, 0.f}, g1 = g2, u2 = g2, u1 = g2;
        const GAS unsigned short* hb = (const GAS unsigned short*)F_HDN + (size_t)r0 * NUP + f;
        auto ld4 = [](const GAS unsigned short* p) -> f32x4 { const u32x2 raw = *(const GAS u32x2*)p; return (f32x4){bflo(raw.x), bfhi(raw.x), bflo(raw.y), bfhi(raw.y)}; };
        if ((r0 & (SEQ - 1)) != 0) { g2 = ld4(hb - 2 * (size_t)NUP); g1 = ld4(hb - (size_t)NUP); u2 = ld4(hb - 2 * (size_t)NUP + DFF); u1 = ld4(hb - (size_t)NUP + DFF); }
        GAS unsigned short* ob = (GAS unsigned short*)F_ACT + ((size_t)chunk * CHROWS + r0) * DFF + f;
#pragma unroll 4
        for (int i = 0; i < 32; ++i) {
            const f32x4 g0 = ld4(hb + (size_t)i * NUP), u0 = ld4(hb + (size_t)i * NUP + DFF);
            const f32x4 cg = bg + wg0 * g2 + wg1 * g1 + wg2 * g0, cu = bu + wu0 * u2 + wu1 * u1 + wu2 * u0;
            const pg8::f32x2 a = pg8::gelu_pk((pg8::f32x2){cg[0], cg[1]}), c2 = pg8::gelu_pk((pg8::f32x2){cg[2], cg[3]});
            u32x2 w; w.x = pk2(a.x * cu[0], a.y * cu[1]); w.y = pk2(c2.x * cu[2], c2.y * cu[3]);
            *(GAS u32x2*)(ob + (size_t)i * DFF) = w;
            g2 = g1; g1 = g0; u2 = u1; u1 = u0;
        }
    }
}

__global__ void __launch_bounds__(NWAVES * 64, 2) fwd(Args args) {
    extern __shared__ __attribute__((aligned(16))) unsigned char lds[];
    Frame F;
    F.lds = (LAS unsigned char*)lds;
    F.MISC = (volatile LAS unsigned*)(F.lds + MISC_OFF);
    F.tid = threadIdx.x; F.lane = F.tid & 63; F.wave = __builtin_amdgcn_readfirstlane(F.tid >> 6);
    F.G = gridDim.x; { const int bx = blockIdx.x; F.vcu = (F.G % 8 == 0) ? (bx % 8) * (F.G / 8) + bx / 8 : bx; }
    F.ws = args.ws; const int vcu0 = F.vcu;
    for (int u = F.tid; u < (LDS_BYTES - LDSCTL_OFF) / 4; u += NWAVES * 64) ((LAS unsigned*)(F.lds + LDSCTL_OFF))[u] = 0u;
    for (int u = F.tid; u < 8 * 129; u += NWAVES * 64) { const int hh = u / 129, n = u % 129; int bk;
        if (n < 16) bk = n; else if (n >= 128) bk = 31; else { bk = 16 + (n >= 19) + (n >= 21) + (n >= 24) + (n >= 27) + (n >= 31) + (n >= 35) + (n >= 40) + (n >= 46) + (n >= 52) + (n >= 59) + (n >= 67) + (n >= 77) + (n >= 87) + (n >= 99) + (n >= 113); }
        ((LAS float*)(F.lds + LUT_OFF))[hh * LUT_STRIDE + n] = inp(6)[bk * 8 + hh]; }
    __syncthreads();
    XcdBarrier bar; bar.bar = (unsigned*)(F_CTL + CW_BAR); bar.x = 0; bar.st = nullptr;
    if (MK_N_LAUNCHES == 1) bar = xcd_barrier_post((unsigned*)(F_CTL + CW_BAR), F.MISC + 8);
#define GRID_BAR() do { if (MK_N_LAUNCHES == 1) xcd_barrier(bar); } while (0)
    const int lo = args.g_lo, hi = args.g_hi;
#define IN(k) (lo <= (k) && (k) < hi)
#define FRESH() do { int t_ = threadIdx.x; asm volatile("" : "+v"(t_)); F.tid = t_; F.lane = t_ & 63; F.wave = __builtin_amdgcn_readfirstlane(t_ >> 6); int v_ = vcu0; asm volatile("" : "+s"(v_)); F.vcu = v_; } while (0)
#define BOTH(k) (IN(k) && IN((k) + 1))
#pragma unroll 1
    for (int l = 0; l < DEPTH; ++l) {
        const int g0 = l * NP;
        if (hi <= g0 || lo >= g0 + NP) continue;
        const float* xcur = (l == 0) ? inp(0) : outp();
        if (IN(g0 + 0)) { FRESH(); p_wconv_rms(F, l, xcur, l == 0 ? outp() : nullptr, inp(1) + l * DM); if (BOTH(g0 + 0)) GRID_BAR(); }
        if (IN(g0 + 1)) {
            pg8::Gemm g{F_XN, F_WinT, MTOK, NPROJ, DM, DM, -1}; pg8::StaticOrder S; S.init(MTOK, NPROJ, F.G, (int)blockIdx.x);
            pg8::EpiBf16<0> E{F_PQ, 1024, nullptr, 1024, (size_t)(WS_PK - WS_PQ) / 2, 1.f};
            pg8::gemm_phase<pg8::EpiBf16<0>, pg8::StaticOrder, true, true>(F.lds + RING_OFF, g, S, E);
            if (BOTH(g0 + 1)) GRID_BAR();
        }
        if (IN(g0 + 2)) { FRESH(); p_prep(F, l); if (BOTH(g0 + 2)) GRID_BAR(); }
        if (IN(g0 + 3)) { FRESH(); p_attn(F); if (BOTH(g0 + 3)) GRID_BAR(); }
        if (IN(g0 + 4)) {
            pg8::Gemm g{F_PQ, F_WbT, MTOK, 4096, 256, 1024, 2}; pg8::StaticOrder S; S.init(MTOK, 4096, F.G, (int)blockIdx.x);
            pg8::EpiBf16<0> E{F_BV, 4096, nullptr, 0, 0, 1.f};
            pg8::gemm_phase<pg8::EpiBf16<0>, pg8::StaticOrder, true, true>(F.lds + RING_OFF, g, S, E);
            if (BOTH(g0 + 4)) GRID_BAR();
        }
        if (IN(g0 + 5)) {
            pg8::Gemm g{F_XN, F_WgT, MTOK, 4096, DM, DM, -1}; pg8::StaticOrder S; S.init(MTOK, 4096, F.G, (int)blockIdx.x);
            pg8::EpiGateMix E{F_BV, F_MIX};
            pg8::gemm_phase<pg8::EpiGateMix, pg8::StaticOrder, true, true>(F.lds + RING_OFF, g, S, E);
            if (BOTH(g0 + 5)) GRID_BAR();
        }
        if (IN(g0 + 6)) {
            pg8::Gemm g{F_MIX, F_WoT, MTOK, DM, DM, DM, -1}; pg8::StaticOrder S; S.init(MTOK, DM, F.G, (int)blockIdx.x);
            pg8::EpiRes E{outp(), outp(), DM};
            pg8::gemm_phase<pg8::EpiRes, pg8::StaticOrder, true, true>(F.lds + RING_OFF, g, S, E);
            if (BOTH(g0 + 6)) GRID_BAR();
        }
        if (IN(g0 + 7)) { FRESH(); p_rms(F, outp(), inp(2) + l * DM); if (BOTH(g0 + 7)) GRID_BAR(); }
#pragma unroll 1
        for (int ch = 0; ch < 2; ++ch) {
            if (IN(g0 + 8 + 2 * ch)) {
                pg8::Gemm g{F_XN + (size_t)ch * CHROWS * DM, F_WupT, CHROWS, NUP, DM, DM, -1}; pg8::StaticOrder S; S.init(CHROWS, NUP, F.G, (int)blockIdx.x);
                pg8::EpiBf16<0> E{F_HDN, NUP, nullptr, 0, 0, 1.f};
                pg8::gemm_phase<pg8::EpiBf16<0>, pg8::StaticOrder, true, true>(F.lds + RING_OFF, g, S, E);
                if (BOTH(g0 + 8 + 2 * ch)) GRID_BAR();
            }
            if (IN(g0 + 9 + 2 * ch)) { FRESH(); p_conv(F, l, ch); if (BOTH(g0 + 9 + 2 * ch)) GRID_BAR(); }
        }
        if (IN(g0 + 12)) {
            pg8::Gemm g{F_ACT, F_WdT, MTOK, DM, DFF, DFF, -1}; pg8::StaticOrder S; S.init(MTOK, DM, F.G, (int)blockIdx.x);
            pg8::EpiRes E{outp(), outp(), DM};
            pg8::gemm_phase<pg8::EpiRes, pg8::StaticOrder, true, true>(F.lds + RING_OFF, g, S, E);
            if (BOTH(g0 + 12)) GRID_BAR();
        }
    }
    if (IN(DEPTH * NP)) { FRESH(); p_final(F, outp(), inp(3)); }
#undef IN
#undef FRESH
#undef BOTH
#undef GRID_BAR
}

extern "C" void kernel_launch(void* const* d_in, const int* in_sizes, int n_in, void* d_out, int out_size, void* d_ws, size_t ws_size, hipStream_t stream) {
    static int grid = 0;
    if (grid == 0) {
        if (n_in != 14 || out_size != MTOK * DM || ws_size < WS_END) { fprintf(stderr, "kernel_launch: unexpected shapes (n_in %d, out %d, ws %zu)\n", n_in, out_size, ws_size); grid = -1; return; }
        int dev = 0, cus = 0, per_cu = 0;
        if (hipGetDevice(&dev) != hipSuccess || hipDeviceGetAttribute(&cus, hipDeviceAttributeMultiprocessorCount, dev) != hipSuccess) { grid = -1; return; }
        if (hipFuncSetAttribute((const void*)fwd, hipFuncAttributeMaxDynamicSharedMemorySize, LDS_BYTES) != hipSuccess) { fprintf(stderr, "kernel_launch: hipFuncSetAttribute failed\n"); grid = -1; return; }
        if (hipOccupancyMaxActiveBlocksPerMultiprocessor(&per_cu, (const void*)fwd, NWAVES * 64, LDS_BYTES) != hipSuccess || per_cu < 1) fprintf(stderr, "kernel_launch: occupancy query reports %d\n", per_cu);
        (void)hipGetLastError();
        grid = cus;
    }
    if (grid < 0) return;
    if (hipMemsetAsync((char*)d_ws + WS_CTL, 0, CTL_ZERO_BYTES, stream) != hipSuccess) return;
    Args a{};
    for (int i = 0; i < 14; ++i) a.in[i] = (const float*)d_in[i];
    a.out = (float*)d_out; a.ws = (unsigned char*)d_ws;
#if MK_N_LAUNCHES == 1
    a.g_lo = 0; a.g_hi = NPH; a.li = 0;
    hipLaunchKernelGGL(fwd, dim3(grid), dim3(NWAVES * 64), LDS_BYTES, stream, a);
#else
    for (int g = 0; g < NPH; ++g) { a.g_lo = g; a.g_hi = g + 1; a.li = g; hipLaunchKernelGGL(fwd, dim3(grid), dim3(NWAVES * 64), LDS_BYTES, stream, a); }
#endif
}
```

```cpp
#include <hip/hip_runtime.h>
#include <cstdio>
#include <cstdint>
#ifndef MK_N_LAUNCHES
#define MK_N_LAUNCHES 1
#endif
namespace pg8 {
#define PG8_LAS __attribute__((address_space(3)))
#define PG8_GAS __attribute__((address_space(1)))
typedef unsigned short bf16_t;
typedef short bf16x8 __attribute__((ext_vector_type(8)));
typedef float f32x4 __attribute__((ext_vector_type(4)));
typedef unsigned u32x4 __attribute__((ext_vector_type(4)));
constexpr int BM = 256, BK = 64, HALF = 128, HTB = HALF * BK * 2  , STAGE_BYTES = 8 * HTB, NXCD = 8, WGM = 8;

__host__ __device__ __forceinline__ int lds_byte(int r, int c) { const int st = (r >> 4) * 2 + (c >> 5), rr = r & 15, cc = c & 31, ob = rr * 64 + cc * 2; return st * 1024 + (ob ^ (((ob >> 9) & 1) << 5)); }
__host__ __device__ __forceinline__ void stage_rc(int b, int& R, int& C) { const int st = b / 1024, sb = b % 1024, swz = sb ^ (((sb >> 9) & 1) << 5); R = (st >> 1) * 16 + swz / 64; C = (st & 1) * 32 + (swz % 64) / 2; }
__host__ __device__ __forceinline__ int perm32(int rho) { const int n = rho >> 4, i = rho & 15; return 8 * (i >> 2) + 4 * n + (i & 3); }

struct Unit { int pm, pn; };
struct Gemm { const bf16_t* A; const bf16_t* Bt; int M, N, K; int lda; int a_sh; size_t kstepA, tstepA; };

struct StaticOrder {
    int nM, nN, nwg, G, c;
    __host__ __device__ void init(int M, int N, int G_, int c_) { nM = M / BM; nN = N / BM; nwg = nM * nN; G = G_; c = c_; }
    __host__ __device__ bool next(int i, Unit& u) const {
        const long L = (long)i * G + c; if (L >= nwg) return false;
        int wgid = (int)L; { const int q = nwg / NXCD, r = nwg % NXCD, xcd = wgid % NXCD, off = wgid / NXCD; wgid = (xcd < r ? xcd * (q + 1) : r * (q + 1) + (xcd - r) * q) + off; }
        const int nig = WGM * nN, gid = wgid / nig, fm = gid * WGM, gsz = (nM - fm) < WGM ? (nM - fm) : WGM;
        u.pm = fm + ((wgid % nig) % gsz); u.pn = (wgid % nig) / gsz; return true;
    }
    __device__ __forceinline__ void a_ready(const Unit&) const {}
    __device__ __forceinline__ void done(const Unit&) const {}
};

__device__ __forceinline__ unsigned cvt_pk_bf16(float lo, float hi) { unsigned r; asm volatile("v_cvt_pk_bf16_f32 %0, %1, %2" : "=v"(r) : "v"(lo), "v"(hi)); return r; }
typedef float f32x2 __attribute__((ext_vector_type(2)));
__device__ __forceinline__ f32x2 gelu_pk(f32x2 v) {
    const f32x2 av = __builtin_elementwise_abs(v), d = av * 0.2316418882f + 1.0f;
    f32x2 t; t.x = __builtin_amdgcn_rcpf(d.x); t.y = __builtin_amdgcn_rcpf(d.y);
    f32x2 q = t * 0.5307027145f + (-0.7265760135f); q = q * t + 0.7107068705f; q = q * t + (-0.142248368f); q = q * t + 0.127414796f; q = q * t;
    const f32x2 s = (v * v) * (-0.72134752044f);
    f32x2 e; e.x = __builtin_amdgcn_exp2f(s.x); e.y = __builtin_amdgcn_exp2f(s.y);
    const f32x2 m = v * (q * e), r = v - m;
    f32x2 o; o.x = v.x < 0.f ? m.x : r.x; o.y = v.y < 0.f ? m.y : r.y; return o;
}

template <int ACT  > struct EpiBf16 {
    static constexpr bool PERM = true, AFTER_DRAIN = false; static_assert(ACT == 0 || ACT == 1, "EpiBf16: ACT is 0 (none) or 1 (gelu_pk)");
    bf16_t* O; int ldc; const float* bias; int split_cols; size_t split_stride; float scale0;
    __device__ __forceinline__ void operator()(const f32x4 (&acc)[2][2][4][2], const Unit& u, int wr, int wc, int fr, int fq) const {
        const int row0 = u.pm * BM + wr * 64 + fr; int colt = u.pn * BM; bf16_t* base = O;
        float sc = 1.f; if (split_cols) { const int t = colt / split_cols; base += (size_t)t * split_stride; colt -= t * split_cols; if (t == 0) sc = scale0; }
        const int col0 = colt + wc * 32 + 8 * fq, bcol0 = u.pn * BM + wc * 32 + 8 * fq;
        f32x4 bv[2][2];
#pragma unroll
        for (int bj = 0; bj < 2; ++bj)
#pragma unroll
            for (int n = 0; n < 2; ++n) bv[bj][n] = bias ? *(const PG8_GAS f32x4*)(bias + bcol0 + bj * HALF + 4 * n) : (f32x4){0.f, 0.f, 0.f, 0.f};
#pragma unroll
        for (int ai = 0; ai < 2; ++ai)
#pragma unroll
            for (int m = 0; m < 4; ++m) { bf16_t* rowp = base + (size_t)(row0 + ai * HALF + m * 16) * ldc + col0;
#pragma unroll
                for (int bj = 0; bj < 2; ++bj) { f32x4 v0 = acc[ai][bj][m][0] + bv[bj][0], v1 = acc[ai][bj][m][1] + bv[bj][1];
                    if (ACT == 1) { f32x2 a = gelu_pk((f32x2){v0[0], v0[1]}), b = gelu_pk((f32x2){v0[2], v0[3]}), c = gelu_pk((f32x2){v1[0], v1[1]}), d = gelu_pk((f32x2){v1[2], v1[3]});
                        v0 = (f32x4){a.x, a.y, b.x, b.y}; v1 = (f32x4){c.x, c.y, d.x, d.y}; }
                    v0 = v0 * sc; v1 = v1 * sc; u32x4 w; w.x = cvt_pk_bf16(v0[0], v0[1]); w.y = cvt_pk_bf16(v0[2], v0[3]); w.z = cvt_pk_bf16(v1[0], v1[1]); w.w = cvt_pk_bf16(v1[2], v1[3]);
                    *(PG8_GAS u32x4*)(rowp + bj * HALF) = w; } }
    }
};
struct EpiRes {
    static constexpr bool PERM = false, AFTER_DRAIN = false;
    const float* base; float* out; int ldc;
    __device__ __forceinline__ void operator()(const f32x4 (&acc)[2][2][4][2], const Unit& u, int wr, int wc, int fr, int fq) const {
        const int row0 = u.pm * BM + wr * 64 + fr, col0 = u.pn * BM + wc * 32 + 4 * fq;
#pragma unroll
        for (int ai = 0; ai < 2; ++ai) {
            f32x4 bs[4][2][2];
#pragma unroll
            for (int m = 0; m < 4; ++m) { const size_t off = (size_t)(row0 + ai * HALF + m * 16) * ldc + col0;
#pragma unroll
                for (int bj = 0; bj < 2; ++bj)
#pragma unroll
                    for (int n = 0; n < 2; ++n) bs[m][bj][n] = *(const f32x4*)(base + off + bj * HALF + n * 16); }
            asm volatile("" ::: "memory");
#pragma unroll
            for (int m = 0; m < 4; ++m) { const size_t off = (size_t)(row0 + ai * HALF + m * 16) * ldc + col0;
#pragma unroll
                for (int bj = 0; bj < 2; ++bj)
#pragma unroll
                    for (int n = 0; n < 2; ++n) *(f32x4*)(out + off + bj * HALF + n * 16) = bs[m][bj][n] + acc[ai][bj][m][n]; }
            asm volatile("" ::: "memory");
        }
    }
};
struct EpiGateMix {
    static constexpr bool PERM = false, AFTER_DRAIN = false;
    const unsigned char* BV; bf16_t* MIX; const unsigned long long* ss;
    __device__ __forceinline__ void operator()(const f32x4 (&acc)[2][2][4][2], const Unit& u, int wr, int wc, int fr, int fq) const {
        typedef unsigned u32x2 __attribute__((ext_vector_type(2)));
        const int row0 = u.pm * BM + wr * 64 + fr, ncol = u.pn * 64 + wc * 16 + 4 * fq;
        unsigned long long ssr[2][4];
#pragma unroll
        for (int ai = 0; ai < 2; ++ai)
#pragma unroll
            for (int m = 0; m < 4; ++m) ssr[ai][m] = ((const PG8_GAS unsigned long long*)ss)[row0 + ai * HALF + m * 16];
        u32x4 raw[4][2]; float scl[4];
        {   const int g = ((u.pn & 3) * 2 + wr) * 4 + wc, l = fq * 16 + fr;
#pragma unroll
            for (int i = 0; i < 4; ++i) { const unsigned char* tile = BV + (size_t)(u.pm * 16 + 4 * i + (u.pn >> 2)) * 73728;
                raw[i][0] = *(const PG8_GAS u32x4*)(tile + (size_t)((2 * g) * 64 + l) * 16); raw[i][1] = *(const PG8_GAS u32x4*)(tile + (size_t)((2 * g + 1) * 64 + l) * 16);
                scl[i] = *(const PG8_GAS float*)(tile + 65536 + (size_t)(64 * g + l) * 4); } }
        asm volatile("" ::: "memory");
        float nsc[4];
#pragma unroll
        for (int i = 0; i < 4; ++i) nsc[i] = -128.0f * scl[i];
#pragma unroll
        for (int ai = 0; ai < 2; ++ai)
#pragma unroll
            for (int m = 0; m < 4; ++m) { const size_t row = (size_t)(row0 + ai * HALF + m * 16);
                const float nrl = -46.16624130844683f * __builtin_amdgcn_rsqf((float)ssr[ai][m] * (1.0f / 65536.0f) + 1024.0e-6f);
                f32x4 sum = (f32x4){0.f, 0.f, 0.f, 0.f};
#pragma unroll
                for (int i = 0; i < 4; ++i) { const f32x4 gte = acc[ai][i >> 1][m][i & 1]; const unsigned rw = raw[i][ai][m];
                    f32x4 bv; bv[0] = fmaf((float)(rw & 0xffu), scl[i], nsc[i]); bv[1] = fmaf((float)((rw >> 8) & 0xffu), scl[i], nsc[i]); bv[2] = fmaf((float)((rw >> 16) & 0xffu), scl[i], nsc[i]); bv[3] = fmaf((float)(rw >> 24), scl[i], nsc[i]);
#pragma unroll
                    for (int e = 0; e < 4; ++e) { const float sg = __builtin_amdgcn_rcpf(1.0f + __builtin_amdgcn_exp2f(nrl * gte[e])); sum[e] += sg * bv[e]; } }
                u32x2 w; w.x = cvt_pk_bf16(sum[0], sum[1]); w.y = cvt_pk_bf16(sum[2], sum[3]);
                *(PG8_GAS u32x2*)(MIX + row * 1024 + ncol) = w; }
    }
};
struct EpiGateMix8 {
    static constexpr bool PERM = false, AFTER_DRAIN = false;
    const unsigned char* BV; bf16_t* MIX; const float* ss; const float* sx; const unsigned* wmax;
    __device__ __forceinline__ void operator()(const int __attribute__((ext_vector_type(4))) (&acc)[2][2][4][2], const Unit& u, int wr, int wc, int fr, int fq) const {
        typedef unsigned u32x2 __attribute__((ext_vector_type(2)));
        const int row0 = u.pm * BM + wr * 64 + fr, ncol = u.pn * 64 + wc * 16 + 4 * fq;
        float ssr[2][4]; float sxr[2][4];
#pragma unroll
        for (int ai = 0; ai < 2; ++ai)
#pragma unroll
            for (int m = 0; m < 4; ++m) { ssr[ai][m] = ((const PG8_GAS float*)ss)[row0 + ai * HALF + m * 16]; sxr[ai][m] = ((const PG8_GAS float*)sx)[row0 + ai * HALF + m * 16]; }
        const unsigned* wmp = wmax; asm volatile("" : "+v"(wmp));
        const float sw = __uint_as_float(*(const PG8_GAS unsigned*)wmp) * (-46.16624130844683f / 127.0f);
        u32x4 raw[4][2]; float scl[4];
        {   const int g = ((u.pn & 3) * 2 + wr) * 4 + wc, l = fq * 16 + fr;
#pragma unroll
            for (int i = 0; i < 4; ++i) { const unsigned char* tile = BV + (size_t)(u.pm * 16 + 4 * i + (u.pn >> 2)) * 73728;
                raw[i][0] = *(const PG8_GAS u32x4*)(tile + (size_t)((2 * g) * 64 + l) * 16); raw[i][1] = *(const PG8_GAS u32x4*)(tile + (size_t)((2 * g + 1) * 64 + l) * 16);
                scl[i] = *(const PG8_GAS float*)(tile + 65536 + (size_t)(64 * g + l) * 4); } }
        asm volatile("" ::: "memory");
        float nsc[4];
#pragma unroll
        for (int i = 0; i < 4; ++i) nsc[i] = -128.0f * scl[i];
#pragma unroll
        for (int ai = 0; ai < 2; ++ai)
#pragma unroll
            for (int m = 0; m < 4; ++m) { const size_t row = (size_t)(row0 + ai * HALF + m * 16);
                const float nrl = sw * sxr[ai][m] * __builtin_amdgcn_rsqf(ssr[ai][m] + 1024.0e-6f);
                f32x4 sum = (f32x4){0.f, 0.f, 0.f, 0.f};
#pragma unroll
                for (int i = 0; i < 4; ++i) { const auto gti = acc[ai][i >> 1][m][i & 1]; const f32x4 gte = (f32x4){(float)gti[0], (float)gti[1], (float)gti[2], (float)gti[3]}; const unsigned rw = raw[i][ai][m];
                    f32x4 bv; bv[0] = fmaf((float)(rw & 0xffu), scl[i], nsc[i]); bv[1] = fmaf((float)((rw >> 8) & 0xffu), scl[i], nsc[i]); bv[2] = fmaf((float)((rw >> 16) & 0xffu), scl[i], nsc[i]); bv[3] = fmaf((float)(rw >> 24), scl[i], nsc[i]);
#pragma unroll
                    for (int e = 0; e < 4; ++e) { const float sg = __builtin_amdgcn_rcpf(1.0f + __builtin_amdgcn_exp2f(nrl * gte[e])); sum[e] = __builtin_fmaf(sg, bv[e], sum[e]); } }
                u32x2 w; w.x = cvt_pk_bf16(sum[0], sum[1]); w.y = cvt_pk_bf16(sum[2], sum[3]);
                *(PG8_GAS u32x2*)(MIX + row * 1024 + ncol) = w; }
    }
};

#define PG8_DPPF(x, ctrl) __builtin_bit_cast(float, __builtin_amdgcn_update_dpp(0, __builtin_bit_cast(int, (x)), (ctrl), 0xf, 0xf, true))
struct EpiConvGelu {
    static constexpr bool PERM = true, AFTER_DRAIN = false;
    bf16_t* ACT; bf16_t* HALO; const float* cw; const float* cb; const unsigned long long* ss;
    __device__ __forceinline__ void operator()(const f32x4 (&acc_)[2][2][4][2], const Unit& u, int wr, int wc, int fr, int fq) const {
        typedef unsigned u32x2 __attribute__((ext_vector_type(2)));
        constexpr int NF = 2816, NU = 5632;
        const int row0 = u.pm * BM + wr * 64 + fr;
        f32x4 (&acc)[2][2][4][2] = const_cast<f32x4 (&)[2][2][4][2]>(acc_);
#pragma unroll
        for (int ai = 0; ai < 2; ++ai)
#pragma unroll
            for (int m = 0; m < 4; ++m) { const float r = 32.0f * __builtin_amdgcn_rsqf((float)((const PG8_GAS unsigned long long*)ss)[row0 + ai * HALF + m * 16] * (1.0f / 65536.0f) + 1024.0e-6f);
#pragma unroll
                for (int bj = 0; bj < 2; ++bj)
#pragma unroll
                    for (int n = 0; n < 2; ++n) acc[ai][bj][m][n] = acc[ai][bj][m][n] * r; }
        u32x2 keep[2][4];
#pragma unroll
        for (int n = 0; n < 2; ++n) {
            const int f = u.pn * 128 + wc * 32 + 8 * fq + 4 * n;
            const f32x4 wg0 = *(const PG8_GAS f32x4*)(cw + f), wg1 = *(const PG8_GAS f32x4*)(cw + NU + f), wg2 = *(const PG8_GAS f32x4*)(cw + 2 * NU + f), bg = *(const PG8_GAS f32x4*)(cb + f);
            const f32x4 wu0 = *(const PG8_GAS f32x4*)(cw + NF + f), wu1 = *(const PG8_GAS f32x4*)(cw + NU + NF + f), wu2 = *(const PG8_GAS f32x4*)(cw + 2 * NU + NF + f), bu = *(const PG8_GAS f32x4*)(cb + NF + f);
#pragma unroll
            for (int ai = 0; ai < 2; ++ai) {
                {   const int chunk = (u.pm * BM + ai * HALF + wr * 64) >> 6;
                    if (fr < 2) { bf16_t* hp = HALO + ((size_t)chunk * 4 + fr) * NU + f; const f32x4 g = acc[ai][0][0][n], uu = acc[ai][1][0][n];
                        u32x2 a, b; a.x = cvt_pk_bf16(g[0], g[1]); a.y = cvt_pk_bf16(g[2], g[3]); b.x = cvt_pk_bf16(uu[0], uu[1]); b.y = cvt_pk_bf16(uu[2], uu[3]);
                        *(PG8_GAS u32x2*)hp = a; *(PG8_GAS u32x2*)(hp + NF) = b; }
                    if (fr >= 14) { bf16_t* hp = HALO + ((size_t)chunk * 4 + (fr - 12)) * NU + f; const f32x4 g = acc[ai][0][3][n], uu = acc[ai][1][3][n];
                        u32x2 a, b; a.x = cvt_pk_bf16(g[0], g[1]); a.y = cvt_pk_bf16(g[2], g[3]); b.x = cvt_pk_bf16(uu[0], uu[1]); b.y = cvt_pk_bf16(uu[2], uu[3]);
                        *(PG8_GAS u32x2*)hp = a; *(PG8_GAS u32x2*)(hp + NF) = b; } }
#pragma unroll
                for (int m = 0; m < 4; ++m) {
                    f32x4 cg, cu;
#pragma unroll
                    for (int e = 0; e < 4; ++e) {
                        const float g = acc[ai][0][m][n][e], uu = acc[ai][1][m][n][e];
                        float a = bg[e] + wg2[e] * g; a = fmaf(wg1[e], PG8_DPPF(g, 0x111), a); a = fmaf(wg0[e], PG8_DPPF(g, 0x112), a);
                        float b = bu[e] + wu2[e] * uu; b = fmaf(wu1[e], PG8_DPPF(uu, 0x111), b); b = fmaf(wu0[e], PG8_DPPF(uu, 0x112), b);
                        if (m > 0) { const float gp = acc[ai][0][m - 1][n][e], up = acc[ai][1][m - 1][n][e];
                            a = fmaf(wg1[e], PG8_DPPF(gp, 0x10f), a); a = fmaf(wg0[e], PG8_DPPF(gp, 0x10e), a);
                            b = fmaf(wu1[e], PG8_DPPF(up, 0x10f), b); b = fmaf(wu0[e], PG8_DPPF(up, 0x10e), b); }
                        cg[e] = a; cu[e] = b; }
                    const f32x2 ga = gelu_pk((f32x2){cg[0], cg[1]}), gb = gelu_pk((f32x2){cg[2], cg[3]});
                    u32x2 w; w.x = cvt_pk_bf16(ga.x * cu[0], ga.y * cu[1]); w.y = cvt_pk_bf16(gb.x * cu[2], gb.y * cu[3]);
                    if (n == 0) keep[ai][m] = w;
                    else { u32x4 o; o.x = keep[ai][m].x; o.y = keep[ai][m].y; o.z = w.x; o.w = w.y; *(PG8_GAS u32x4*)(ACT + (((size_t)u.pm * (NF / 64) + ((f - 4) >> 6)) * 256 + (wr * 64 + fr + ai * HALF + m * 16)) * 64 + ((f - 4) & 63)) = o; } }
            }
        }
    }
};

struct EpiConvGelu8 {
    static constexpr bool PERM = true, AFTER_DRAIN = false;
    bf16_t* ACT; bf16_t* HALO; const float* cw; const float* cb; const float* ss; const float* sx; const float* cmax;
    __device__ __forceinline__ void operator()(const int __attribute__((ext_vector_type(4))) (&acc_)[2][2][4][2], const Unit& u, int wr, int wc, int fr, int fq) const {
        typedef unsigned u32x2 __attribute__((ext_vector_type(2)));
        constexpr int NF = 2816, NU = 5632;
        const int row0 = u.pm * BM + wr * 64 + fr;
        f32x4 acc[2][2][4][2];
        const float sw = 32.0f;
#pragma unroll
        for (int ai = 0; ai < 2; ++ai)
#pragma unroll
            for (int m = 0; m < 4; ++m) { const float r = sw * ((const PG8_GAS float*)sx)[row0 + ai * HALF + m * 16] * __builtin_amdgcn_rsqf(((const PG8_GAS float*)ss)[row0 + ai * HALF + m * 16] + 1024.0e-6f);
#pragma unroll
                for (int bj = 0; bj < 2; ++bj)
#pragma unroll
                    for (int n = 0; n < 2; ++n) { const auto t = acc_[ai][bj][m][n]; acc[ai][bj][m][n] = (f32x4){(float)t[0], (float)t[1], (float)t[2], (float)t[3]} * r; } }
        u32x2 keep[2][4];
#pragma unroll
        for (int n = 0; n < 2; ++n) {
            const int f = u.pn * 128 + wc * 32 + 8 * fq + 4 * n;
            const f32x4 swg = *(const PG8_GAS f32x4*)(cmax + f) * (1.0f / 127.0f), swu = *(const PG8_GAS f32x4*)(cmax + NF + f) * (1.0f / 127.0f);
            const f32x4 wg0 = *(const PG8_GAS f32x4*)(cw + f) * swg, wg1 = *(const PG8_GAS f32x4*)(cw + NU + f) * swg, wg2 = *(const PG8_GAS f32x4*)(cw + 2 * NU + f) * swg, bg = *(const PG8_GAS f32x4*)(cb + f);
            const f32x4 wu0 = *(const PG8_GAS f32x4*)(cw + NF + f) * swu, wu1 = *(const PG8_GAS f32x4*)(cw + NU + NF + f) * swu, wu2 = *(const PG8_GAS f32x4*)(cw + 2 * NU + NF + f) * swu, bu = *(const PG8_GAS f32x4*)(cb + NF + f);
#pragma unroll
            for (int ai = 0; ai < 2; ++ai) {
                {   const int chunk = (u.pm * BM + ai * HALF + wr * 64) >> 6;
                    if (fr < 2) { bf16_t* hp = HALO + ((size_t)chunk * 4 + fr) * NU + f; const f32x4 g = acc[ai][0][0][n], uu = acc[ai][1][0][n];
                        u32x2 a, b; a.x = cvt_pk_bf16(g[0], g[1]); a.y = cvt_pk_bf16(g[2], g[3]); b.x = cvt_pk_bf16(uu[0], uu[1]); b.y = cvt_pk_bf16(uu[2], uu[3]);
                        *(PG8_GAS u32x2*)hp = a; *(PG8_GAS u32x2*)(hp + NF) = b; }
                    if (fr >= 14) { bf16_t* hp = HALO + ((size_t)chunk * 4 + (fr - 12)) * NU + f; const f32x4 g = acc[ai][0][3][n], uu = acc[ai][1][3][n];
                        u32x2 a, b; a.x = cvt_pk_bf16(g[0], g[1]); a.y = cvt_pk_bf16(g[2], g[3]); b.x = cvt_pk_bf16(uu[0], uu[1]); b.y = cvt_pk_bf16(uu[2], uu[3]);
                        *(PG8_GAS u32x2*)hp = a; *(PG8_GAS u32x2*)(hp + NF) = b; } }
#pragma unroll
                for (int m = 0; m < 4; ++m) {
#define PG8_TAP8(CTRL, G, U, WG, WU) asm("s_nop 1\n\t" \
                        "v_fmac_f32_dpp %0, %8, %16 " CTRL " row_mask:0xf bank_mask:0xf bound_ctrl:1\n\tv_fmac_f32_dpp %1, %9, %17 " CTRL " row_mask:0xf bank_mask:0xf bound_ctrl:1\n\t" \
                        "v_fmac_f32_dpp %2, %10, %18 " CTRL " row_mask:0xf bank_mask:0xf bound_ctrl:1\n\tv_fmac_f32_dpp %3, %11, %19 " CTRL " row_mask:0xf bank_mask:0xf bound_ctrl:1\n\t" \
                        "v_fmac_f32_dpp %4, %12, %20 " CTRL " row_mask:0xf bank_mask:0xf bound_ctrl:1\n\tv_fmac_f32_dpp %5, %13, %21 " CTRL " row_mask:0xf bank_mask:0xf bound_ctrl:1\n\t" \
                        "v_fmac_f32_dpp %6, %14, %22 " CTRL " row_mask:0xf bank_mask:0xf bound_ctrl:1\n\tv_fmac_f32_dpp %7, %15, %23 " CTRL " row_mask:0xf bank_mask:0xf bound_ctrl:1" \
                        : "+v"(ca0), "+v"(ca1), "+v"(ca2), "+v"(ca3), "+v"(cb0), "+v"(cb1), "+v"(cb2), "+v"(cb3) \
                        : "v"(G[0]), "v"(G[1]), "v"(G[2]), "v"(G[3]), "v"(U[0]), "v"(U[1]), "v"(U[2]), "v"(U[3]), "v"(WG[0]), "v"(WG[1]), "v"(WG[2]), "v"(WG[3]), "v"(WU[0]), "v"(WU[1]), "v"(WU[2]), "v"(WU[3]))
                    f32x4 cg, cu;
                    {   const f32x4 gv = acc[ai][0][m][n], uv = acc[ai][1][m][n];
                        const f32x4 ia = bg + wg2 * gv, ib = bu + wu2 * uv;
                        float ca0 = ia[0], ca1 = ia[1], ca2 = ia[2], ca3 = ia[3], cb0 = ib[0], cb1 = ib[1], cb2 = ib[2], cb3 = ib[3];
                        PG8_TAP8("row_shr:1", gv, uv, wg1, wu1); PG8_TAP8("row_shr:2", gv, uv, wg0, wu0);
                        if (m > 0) { const f32x4 gp = acc[ai][0][m - 1][n], up = acc[ai][1][m - 1][n];
                            PG8_TAP8("row_shl:15", gp, up, wg1, wu1); PG8_TAP8("row_shl:14", gp, up, wg0, wu0); }
                        cg = (f32x4){ca0, ca1, ca2, ca3}; cu = (f32x4){cb0, cb1, cb2, cb3}; }
#undef PG8_TAP8
                    const f32x2 ga = gelu_pk((f32x2){cg[0], cg[1]}), gb = gelu_pk((f32x2){cg[2], cg[3]});
                    u32x2 w; w.x = cvt_pk_bf16(ga.x * cu[0], ga.y * cu[1]); w.y = cvt_pk_bf16(gb.x * cu[2], gb.y * cu[3]);
                    if (n == 0) keep[ai][m] = w;
                    else { u32x4 o; o.x = keep[ai][m].x; o.y = keep[ai][m].y; o.z = w.x; o.w = w.y; *(PG8_GAS u32x4*)(ACT + (((size_t)u.pm * (NF / 64) + ((f - 4) >> 6)) * 256 + (wr * 64 + fr + ai * HALF + m * 16)) * 64 + ((f - 4) & 63)) = o; } }
            }
        }
    }
};

struct EpiNull {
    static constexpr bool PERM = true, AFTER_DRAIN = false;
    __device__ __forceinline__ void operator()(const f32x4 (&acc)[2][2][4][2], const Unit& u, int wr, int wc, int fr, int fq) const {
#pragma unroll
        for (int ai = 0; ai < 2; ++ai)
#pragma unroll
            for (int bj = 0; bj < 2; ++bj)
#pragma unroll
                for (int m = 0; m < 4; ++m) asm volatile("" :: "v"(acc[ai][bj][m][0]), "v"(acc[ai][bj][m][1]));
    }
};

struct EpiBf16T {
    static constexpr bool PERM = true, AFTER_DRAIN = false;
    bf16_t* O; int ldc; PG8_LAS unsigned char* stg;
    __device__ __forceinline__ void operator()(const f32x4 (&acc)[2][2][4][2], const Unit& u, int wr, int wc, int fr, int fq) const {
        int fr_ = fr, fq_ = fq; asm volatile("" : "+v"(fr_), "+v"(fq_));
        const int lane = fq_ * 16 + fr_; PG8_LAS unsigned char* my = stg + (wr * 4 + wc) * 1280;
        PG8_LAS u32x4* wp = (PG8_LAS u32x4*)(my + fr_ * 80 + fq_ * 16); const PG8_LAS u32x4* rp = (const PG8_LAS u32x4*)(my + (lane >> 2) * 80 + (lane & 3) * 16);
        bf16_t* ob = O + (size_t)(u.pm * BM + wr * 64 + (lane >> 2)) * ldc + u.pn * BM + wc * 32 + (lane & 3) * 8;
#pragma unroll
        for (int ai = 0; ai < 2; ++ai)
#pragma unroll
            for (int m = 0; m < 4; ++m)
#pragma unroll
                for (int bj = 0; bj < 2; ++bj) { const f32x4 v0 = acc[ai][bj][m][0], v1 = acc[ai][bj][m][1];
                    u32x4 w; w.x = cvt_pk_bf16(v0[0], v0[1]); w.y = cvt_pk_bf16(v0[2], v0[3]); w.z = cvt_pk_bf16(v1[0], v1[1]); w.w = cvt_pk_bf16(v1[2], v1[3]);
                    *wp = w; asm volatile("s_waitcnt lgkmcnt(0)" ::: "memory");
                    const u32x4 t = *rp; asm volatile("s_waitcnt lgkmcnt(0)" ::: "memory");
                    *(u32x4*)(ob + (size_t)(ai * HALF + m * 16) * ldc + bj * HALF) = t; }
    }
};

struct EpiProj3 {
    static constexpr bool PERM = true, AFTER_DRAIN = false;
    bf16_t* O; size_t split_stride;
    __device__ __forceinline__ void operator()(const f32x4 (&acc)[2][2][4][2], const Unit& u, int wr, int wc, int fr, int fq) const {
        const int row0 = u.pm * BM + wr * 64 + fr; const int colt = u.pn * BM; const int t = colt >> 10;
        bf16_t* base = O + (size_t)t * split_stride + (size_t)row0 * 1024 + ((colt & 1023) + wc * 32 + 8 * fq);
#pragma unroll
        for (int ai = 0; ai < 2; ++ai)
#pragma unroll
            for (int m = 0; m < 4; ++m)
#pragma unroll
                for (int bj = 0; bj < 2; ++bj) { const f32x4 v0 = acc[ai][bj][m][0], v1 = acc[ai][bj][m][1];
                    u32x4 w; w.x = cvt_pk_bf16(v0[0], v0[1]); w.y = cvt_pk_bf16(v0[2], v0[3]); w.z = cvt_pk_bf16(v1[0], v1[1]); w.w = cvt_pk_bf16(v1[2], v1[3]);
                    *(u32x4*)(base + (size_t)(ai * HALF + m * 16) * 1024 + bj * HALF) = w; }
    }
};

struct EpiHalf {
    static constexpr bool PERM = true, AFTER_DRAIN = false;
    bf16_t* O; int ldc;
    __device__ __forceinline__ void operator()(const f32x4 (&acc)[2][2][4][2], const Unit& u, int wr, int wc, int fr, int fq) const {
        bf16_t* base = O + (size_t)(u.pm * BM + wr * 64 + fr) * ldc + u.pn * BM + wc * 32 + 8 * fq;
#pragma unroll
        for (int m = 0; m < 4; ++m)
#pragma unroll
            for (int bj = 0; bj < 2; ++bj) { const f32x4 v0 = acc[0][bj][m][0], v1 = acc[0][bj][m][1];
                u32x4 w; w.x = cvt_pk_bf16(v0[0], v0[1]); w.y = cvt_pk_bf16(v0[2], v0[3]); w.z = cvt_pk_bf16(v1[0], v1[1]); w.w = cvt_pk_bf16(v1[2], v1[3]);
                *(u32x4*)(base + (size_t)(m * 16) * ldc + bj * HALF) = w; }
#pragma unroll
        for (int bj = 0; bj < 2; ++bj)
#pragma unroll
            for (int m = 0; m < 4; ++m) asm volatile("" :: "v"(acc[1][bj][m][0]), "v"(acc[1][bj][m][1]));
    }
};

template <bool ATOM = true> struct EpiResBT {
    static constexpr bool PERM = true, AFTER_DRAIN = false;
    bf16_t* xb; int ldc; float* ss; PG8_LAS float* sq;
    __device__ __forceinline__ void operator()(const f32x4 (&acc)[2][2][4][2], const Unit& u, int wr, int wc, int fr, int fq) const {
        bf16_t* base = xb + (size_t)(u.pm * BM + wr * 64 + fr) * ldc + u.pn * BM + wc * 32 + 8 * fq;
#pragma unroll
        for (int ai = 0; ai < 2; ++ai) {
            u32x4 bs[4][2];
#pragma unroll
            for (int m = 0; m < 4; ++m)
#pragma unroll
                for (int bj = 0; bj < 2; ++bj) bs[m][bj] = *(const PG8_GAS u32x4*)(base + (size_t)(ai * HALF + m * 16) * ldc + bj * HALF);
            asm volatile("" ::: "memory");
#pragma unroll
            for (int m = 0; m < 4; ++m) { float sqv = 0.f;
#pragma unroll
                for (int bj = 0; bj < 2; ++bj) { const u32x4 r = bs[m][bj]; const f32x4 a0 = acc[ai][bj][m][0], a1 = acc[ai][bj][m][1];
                    const float x0 = __uint_as_float(r.x << 16) + a0[0], x1 = __uint_as_float(r.x & 0xffff0000u) + a0[1], x2 = __uint_as_float(r.y << 16) + a0[2], x3 = __uint_as_float(r.y & 0xffff0000u) + a0[3];
                    const float x4 = __uint_as_float(r.z << 16) + a1[0], x5 = __uint_as_float(r.z & 0xffff0000u) + a1[1], x6 = __uint_as_float(r.w << 16) + a1[2], x7 = __uint_as_float(r.w & 0xffff0000u) + a1[3];
                    sqv += ((x0 * x0 + x1 * x1) + (x2 * x2 + x3 * x3)) + ((x4 * x4 + x5 * x5) + (x6 * x6 + x7 * x7));
                    u32x4 w; w.x = cvt_pk_bf16(x0, x1); w.y = cvt_pk_bf16(x2, x3); w.z = cvt_pk_bf16(x4, x5); w.w = cvt_pk_bf16(x6, x7);
                    *(PG8_GAS u32x4*)(base + (size_t)(ai * HALF + m * 16) * ldc + bj * HALF) = w; }
                { auto r16 = __builtin_amdgcn_permlane16_swap(__float_as_uint(sqv), __float_as_uint(sqv), false, false); sqv = __uint_as_float(r16[0]) + __uint_as_float(r16[1]);
                  auto r32 = __builtin_amdgcn_permlane32_swap(__float_as_uint(sqv), __float_as_uint(sqv), false, false); sqv = __uint_as_float(r32[0]) + __uint_as_float(r32[1]); }
                if (ATOM && fq == 0) sq[wc * 256 + wr * 64 + fr + ai * HALF + m * 16] = sqv; }
            asm volatile("" ::: "memory");
        }
        if (ATOM) {
            asm volatile("s_waitcnt lgkmcnt(0)" ::: "memory"); __builtin_amdgcn_s_barrier();
            if (wr == 0) { const int t = wc * 64 + fq * 16 + fr;
                const float s4 = (sq[t] + sq[256 + t]) + (sq[512 + t] + sq[768 + t]);
                ((PG8_GAS float*)ss)[(size_t)(u.pm * BM + t) * 4 + u.pn] = s4; }
        }
    }
};
typedef EpiResBT<true> EpiResB;

struct EpiBvTile {
    static constexpr bool PERM = true, AFTER_DRAIN = false;
    bf16_t* BV;
    __device__ __forceinline__ void operator()(const f32x4 (&acc)[2][2][4][2], const Unit& u, int wr, int wc, int fr, int fq) const {
        int l_; asm volatile("v_mbcnt_lo_u32_b32 %0, -1, 0\n\tv_mbcnt_hi_u32_b32 %0, -1, %0" : "=v"(l_)); const int fr_ = l_ & 15, fq_ = l_ >> 4; (void)fr; (void)fq;
        bf16_t* base = BV + ((size_t)(u.pm * 16 + u.pn) * 256 + wr * 64 + fr_) * 256 + wc * 32 + 8 * fq_;
#pragma unroll
        for (int ai = 0; ai < 2; ++ai)
#pragma unroll
            for (int m = 0; m < 4; ++m)
#pragma unroll
                for (int bj = 0; bj < 2; ++bj) { const f32x4 v0 = acc[ai][bj][m][0], v1 = acc[ai][bj][m][1];
                    u32x4 w; w.x = cvt_pk_bf16(v0[0], v0[1]); w.y = cvt_pk_bf16(v0[2], v0[3]); w.z = cvt_pk_bf16(v1[0], v1[1]); w.w = cvt_pk_bf16(v1[2], v1[3]);
                    *(PG8_GAS u32x4*)(base + (size_t)(ai * HALF + m * 16) * 256 + bj * HALF) = w; }
    }
};

constexpr int BVQ_TILE = 65536 + 8192;
struct EpiBvQ8 {
    static constexpr bool PERM = false, AFTER_DRAIN = false;
    unsigned char* BV;
    __device__ __forceinline__ void operator()(const f32x4 (&acc)[2][2][4][2], const Unit& u, int wr, int wc, int fr, int fq) const {
        int l_; asm volatile("v_mbcnt_lo_u32_b32 %0, -1, 0\n\tv_mbcnt_hi_u32_b32 %0, -1, %0" : "=v"(l_)); (void)fr; (void)fq;
        unsigned char* tile = BV + (size_t)(u.pm * 16 + u.pn) * BVQ_TILE;
#pragma unroll
        for (int bj = 0; bj < 2; ++bj)
#pragma unroll
            for (int n = 0; n < 2; ++n) {
                const int g = ((2 * bj + (wc >> 1)) * 2 + wr) * 4 + 2 * (wc & 1) + n;
                float amax = 1.0e-30f;
#pragma unroll
                for (int ai = 0; ai < 2; ++ai)
#pragma unroll
                    for (int m = 0; m < 4; ++m) { const f32x4 v = acc[ai][bj][m][n]; amax = fmaxf(fmaxf(amax, fabsf(v[0])), fmaxf(fabsf(v[1]), fmaxf(fabsf(v[2]), fabsf(v[3])))); }
                const float inv = 127.0f * __builtin_amdgcn_rcpf(amax);
#pragma unroll
                for (int ai = 0; ai < 2; ++ai) { u32x4 w;
#pragma unroll
                    for (int m = 0; m < 4; ++m) { const f32x4 v = acc[ai][bj][m][n];
                        const unsigned b0 = __float_as_uint(fmaf(v[0], inv, 12583040.0f)), b1 = __float_as_uint(fmaf(v[1], inv, 12583040.0f)), b2 = __float_as_uint(fmaf(v[2], inv, 12583040.0f)), b3 = __float_as_uint(fmaf(v[3], inv, 12583040.0f));
                        w[m] = __builtin_amdgcn_perm(b1, b0, 0x0c0c0400u) | __builtin_amdgcn_perm(b3, b2, 0x04000c0cu); }
                    *(PG8_GAS u32x4*)(tile + ((size_t)((2 * g + ai) * 64 + l_)) * 16) = w; }
                *(PG8_GAS float*)(tile + 65536 + (size_t)(64 * g + l_) * 4) = amax * (1.0f / 127.0f);
            }
    }
};

struct EpiProjS {
    static constexpr bool PERM = true, AFTER_DRAIN = false;
    bf16_t* O; size_t split_stride; const float* ss;
    __device__ __forceinline__ void operator()(const f32x4 (&acc)[2][2][4][2], const Unit& u, int wr, int wc, int fr, int fq) const {
        const int row0 = u.pm * BM + wr * 64 + fr; const int colt = u.pn * BM; const int t = colt >> 10;
        bf16_t* base = O + (size_t)t * split_stride + (size_t)row0 * 1024 + ((colt & 1023) + wc * 32 + 8 * fq);
        f32x4 ssr[2][4];
#pragma unroll
        for (int ai = 0; ai < 2; ++ai)
#pragma unroll
            for (int m = 0; m < 4; ++m) ssr[ai][m] = ((const PG8_GAS f32x4*)ss)[row0 + ai * HALF + m * 16];
#pragma unroll
        for (int ai = 0; ai < 2; ++ai)
#pragma unroll
            for (int m = 0; m < 4; ++m) { const float r = 32.0f * __builtin_amdgcn_rsqf(((ssr[ai][m][0] + ssr[ai][m][1]) + (ssr[ai][m][2] + ssr[ai][m][3])) + 1024.0e-6f);
#pragma unroll
                for (int bj = 0; bj < 2; ++bj) { const f32x4 v0 = acc[ai][bj][m][0] * r, v1 = acc[ai][bj][m][1] * r;
                    u32x4 w; w.x = cvt_pk_bf16(v0[0], v0[1]); w.y = cvt_pk_bf16(v0[2], v0[3]); w.z = cvt_pk_bf16(v1[0], v1[1]); w.w = cvt_pk_bf16(v1[2], v1[3]);
                    *(PG8_GAS u32x4*)(base + (size_t)(ai * HALF + m * 16) * 1024 + bj * HALF) = w; } }
    }
};

struct EpiProjS8 {
    static constexpr bool PERM = true, AFTER_DRAIN = false;
    bf16_t* O; size_t split_stride; const float* ss; const float* sx; const float* sw;
    __device__ __forceinline__ void operator()(const int __attribute__((ext_vector_type(4))) (&acc)[2][2][4][2], const Unit& u, int wr, int wc, int fr, int fq) const {
        const int row0 = u.pm * BM + wr * 64 + fr; const int colt = u.pn * BM; const int t = colt >> 10;
        bf16_t* base = O + (size_t)t * split_stride + (size_t)row0 * 1024 + ((colt & 1023) + wc * 32 + 8 * fq);
        float ssr[2][4], sxr[2][4]; f32x4 cw[2][2];
#pragma unroll
        for (int ai = 0; ai < 2; ++ai)
#pragma unroll
            for (int m = 0; m < 4; ++m) { ssr[ai][m] = ((const PG8_GAS float*)ss)[row0 + ai * HALF + m * 16]; sxr[ai][m] = ((const PG8_GAS float*)sx)[row0 + ai * HALF + m * 16]; }
#pragma unroll
        for (int bj = 0; bj < 2; ++bj)
#pragma unroll
            for (int n = 0; n < 2; ++n) cw[bj][n] = *(const PG8_GAS f32x4*)(sw + colt + wc * 32 + 8 * fq + bj * HALF + 4 * n);
#pragma unroll
        for (int ai = 0; ai < 2; ++ai)
#pragma unroll
            for (int m = 0; m < 4; ++m) { const float r = 32.0f * sxr[ai][m] * __builtin_amdgcn_rsqf(ssr[ai][m] + 1024.0e-6f);
#pragma unroll
                for (int bj = 0; bj < 2; ++bj) { const auto i0 = acc[ai][bj][m][0], i1 = acc[ai][bj][m][1];
                    const f32x4 v0 = (f32x4){(float)i0[0], (float)i0[1], (float)i0[2], (float)i0[3]} * r * cw[bj][0], v1 = (f32x4){(float)i1[0], (float)i1[1], (float)i1[2], (float)i1[3]} * r * cw[bj][1];
                    u32x4 w; w.x = cvt_pk_bf16(v0[0], v0[1]); w.y = cvt_pk_bf16(v0[2], v0[3]); w.z = cvt_pk_bf16(v1[0], v1[1]); w.w = cvt_pk_bf16(v1[2], v1[3]);
                    *(PG8_GAS u32x4*)(base + (size_t)(ai * HALF + m * 16) * 1024 + bj * HALF) = w; } }
    }
};
typedef int i32x4 __attribute__((ext_vector_type(4)));
template <bool B, class T, class U> struct pg8_cond { typedef T type; };
template <class T, class U> struct pg8_cond<false, T, U> { typedef U type; };
template <class T> __device__ __forceinline__ T pg8_zero4() { T t; t[0] = 0; t[1] = 0; t[2] = 0; t[3] = 0; return t; }
template <class Epi, class Sched, bool ALIGN_EPI = false, bool SP2 = false, bool I8 = false>
__device__ __forceinline__ void gemm_phase(PG8_LAS unsigned char* lds, const Gemm g, const Sched& S, const Epi& E, int tid_in) {
    int tid_ = tid_in; asm volatile("" : "+v"(tid_));
    const int tid = tid_, wid = __builtin_amdgcn_readfirstlane(tid >> 6), lane = tid & 63, wr = wid >> 2, wc = wid & 3, fr = lane & 15, fq = lane >> 4;
    const int K = g.K, nt = K / BK;
    unsigned voffA[2], voffB[2];
#pragma unroll
    for (int i = 0; i < 2; ++i) { int R, C; stage_rc(tid * 16 + i * 8192, R, C); const int Rb = Epi::PERM ? ((R & ~31) + perm32(R & 31)) : R;
        voffA[i] = (unsigned)(R * g.lda + C) * 2u; voffB[i] = (unsigned)(Rb * K + C) * 2u; }
    const size_t kstep = (size_t)(BK * 2);
    const size_t hstepA = (size_t)HALF * g.lda * 2, hstepB = (size_t)HALF * K * 2;
    const size_t tstepA = g.tstepA ? g.tstepA : 2 * hstepA, tstepB = 2 * hstepB;
    const size_t kstepA = g.kstepA ? g.kstepA : kstep;
#define PG8_AOFF(u) ((size_t)(u).pm * tstepA + (g.a_sh >= 0 ? (size_t)((u).pn >> g.a_sh) * (size_t)K * 2 : (size_t)0))
    const unsigned ldsw = (unsigned)wid * 1024u;
    const int aoff = lds_byte(wr * 64 + fr, fq * 8), boff = lds_byte(wc * 32 + fr, fq * 8);
#define PG8_SA(b, h) (((b) * 2 + (h)) * HTB)
#define PG8_SB(b, h) ((4 + (b) * 2 + (h)) * HTB)
#define PG8_STAGE(bufoff, gbase, voff) do { _Pragma("unroll") for (int _i = 0; _i < 2; ++_i) \
        __builtin_amdgcn_global_load_lds((const unsigned*)((const char*)(gbase) + (voff)[_i]), (PG8_LAS unsigned*)(lds + (bufoff) + ldsw + _i * 8192), 16, 0, 0); } while (0)
#define PG8_LDA(dst, b, h) do { _Pragma("unroll") for (int m = 0; m < 4; ++m) _Pragma("unroll") for (int k = 0; k < 2; ++k) dst[m][k] = *(const PG8_LAS bf16x8*)(lds + PG8_SA(b, h) + aoff + m * 2048 + k * 1024); } while (0)
#define PG8_LDB(dst, b, h) do { _Pragma("unroll") for (int n = 0; n < 2; ++n) _Pragma("unroll") for (int k = 0; k < 2; ++k) dst[n][k] = *(const PG8_LAS bf16x8*)(lds + PG8_SB(b, h) + boff + n * 2048 + k * 1024); } while (0)
#define PG8_MMA(ai, bj, At, Bt) do { __builtin_amdgcn_s_setprio(1); _Pragma("unroll") for (int m = 0; m < 4; ++m) _Pragma("unroll") for (int n = 0; n < 2; ++n) _Pragma("unroll") for (int k = 0; k < 2; ++k) \
        { if constexpr (I8) acc[ai][bj][m][n] = __builtin_amdgcn_mfma_i32_16x16x64_i8(__builtin_bit_cast(i32x4, Bt[n][k]), __builtin_bit_cast(i32x4, At[m][k]), acc[ai][bj][m][n], 0, 0, 0); \
          else acc[ai][bj][m][n] = __builtin_amdgcn_mfma_f32_16x16x32_bf16(Bt[n][k], At[m][k], acc[ai][bj][m][n], 0, 0, 0); } __builtin_amdgcn_s_setprio(0); } while (0)
#define PG8_WAIT_V(n) asm volatile("s_waitcnt vmcnt(" #n ")" ::: "memory")
#define PG8_WAIT_L(n) asm volatile("s_waitcnt lgkmcnt(" #n ")" ::: "memory")
#define PG8_BAR __builtin_amdgcn_s_barrier()
#define PG8_SCHED __builtin_amdgcn_sched_barrier(0)
    Unit cur, nxt; int ui = 0;
    if (!S.next(0, cur)) return;
    typedef typename pg8_cond<I8, i32x4, f32x4>::type acc_t;
    acc_t acc[2][2][4][2];
#pragma unroll
    for (int a = 0; a < 2; ++a)
#pragma unroll
        for (int b = 0; b < 2; ++b)
#pragma unroll
            for (int m = 0; m < 4; ++m)
#pragma unroll
                for (int n = 0; n < 2; ++n) acc[a][b][m][n] = pg8_zero4<acc_t>();
    bf16x8 At[4][2], B0[2][2], B1[2][2];
    const char* cA = (const char*)g.A + PG8_AOFF(cur); const char* cB = (const char*)g.Bt + (size_t)cur.pn * tstepB;
    S.a_ready(cur);
    if constexpr (SP2) {
        PG8_STAGE(PG8_SB(0, 0), cB, voffB); PG8_STAGE(PG8_SB(0, 1), cB + hstepB, voffB); PG8_STAGE(PG8_SA(0, 0), cA, voffA); PG8_STAGE(PG8_SA(0, 1), cA + hstepA, voffA);
        if (wr == 1) PG8_BAR;
        PG8_WAIT_V(2); PG8_BAR;
        PG8_STAGE(PG8_SB(1, 0), cB + kstep, voffB); PG8_STAGE(PG8_SA(1, 0), cA + kstepA, voffA); PG8_STAGE(PG8_SB(1, 1), cB + hstepB + kstep, voffB);
        PG8_WAIT_V(6); PG8_BAR;
    } else {
        PG8_STAGE(PG8_SB(0, 0), cB, voffB); PG8_STAGE(PG8_SA(0, 0), cA, voffA); PG8_STAGE(PG8_SB(0, 1), cB + hstepB, voffB); PG8_STAGE(PG8_SA(0, 1), cA + hstepA, voffA);
        if (wr == 1) PG8_BAR;
        PG8_WAIT_V(4); PG8_BAR;
        PG8_STAGE(PG8_SB(1, 0), cB + kstep, voffB); PG8_STAGE(PG8_SA(1, 0), cA + kstepA, voffA); PG8_STAGE(PG8_SB(1, 1), cB + hstepB + kstep, voffB);
        PG8_WAIT_V(6); PG8_BAR;
    }
    for (;;) {
        const bool has_next = S.next(ui + 1, nxt);
        const char* nA = has_next ? (const char*)g.A + PG8_AOFF(nxt) : cA; const char* nB = has_next ? (const char*)g.Bt + (size_t)nxt.pn * tstepB : cB;
        for (int t = 0; t < nt; t += 2) {
            const bool last = (t == nt - 2);
            const char* a1 = cA + (size_t)(t + 1) * kstepA;
            const char* a2 = last ? nA : cA + (size_t)(t + 2) * kstepA; const char* b2 = last ? nB : cB + (size_t)(t + 2) * kstep;
            const char* a3 = a2 + kstepA; const char* b3 = b2 + kstep;
            if (last && has_next) S.a_ready(nxt);
            if constexpr (SP2) {
            PG8_LDB(B0, 0, 0); PG8_LDB(B1, 0, 1); PG8_SCHED; PG8_LDA(At, 0, 0); PG8_STAGE(PG8_SA(1, 1), a1 + hstepA, voffA);
            PG8_WAIT_V(8); PG8_WAIT_L(0); PG8_BAR; PG8_MMA(0, 0, At, B0); PG8_MMA(0, 1, At, B1); PG8_BAR; PG8_SCHED;
            PG8_LDA(At, 0, 1); PG8_STAGE(PG8_SB(0, 0), b2, voffB); PG8_STAGE(PG8_SB(0, 1), b2 + hstepB, voffB); PG8_STAGE(PG8_SA(0, 0), a2, voffA);
            PG8_WAIT_V(8); PG8_WAIT_L(0); PG8_BAR; PG8_MMA(1, 0, At, B0); PG8_MMA(1, 1, At, B1); PG8_BAR; PG8_SCHED;
            PG8_LDB(B0, 1, 0); PG8_LDB(B1, 1, 1); PG8_SCHED; PG8_LDA(At, 1, 0); PG8_STAGE(PG8_SA(0, 1), a2 + hstepA, voffA);
            PG8_WAIT_V(8); PG8_WAIT_L(0); PG8_BAR; PG8_MMA(0, 0, At, B0); PG8_MMA(0, 1, At, B1); PG8_BAR; PG8_SCHED;
            PG8_LDA(At, 1, 1); PG8_STAGE(PG8_SB(1, 0), b3, voffB); PG8_STAGE(PG8_SB(1, 1), b3 + hstepB, voffB); PG8_STAGE(PG8_SA(1, 0), a3, voffA);
            PG8_WAIT_V(8); PG8_WAIT_L(0); PG8_BAR; PG8_MMA(1, 0, At, B0); PG8_MMA(1, 1, At, B1); PG8_BAR; PG8_SCHED;
            } else {
            PG8_LDB(B0, 0, 0); PG8_SCHED; PG8_LDA(At, 0, 0); PG8_STAGE(PG8_SA(1, 1), a1 + hstepA, voffA);
            PG8_WAIT_L(8); PG8_BAR; PG8_WAIT_L(0); PG8_MMA(0, 0, At, B0); PG8_BAR; PG8_SCHED;
            PG8_LDB(B1, 0, 1); PG8_STAGE(PG8_SB(0, 0), b2, voffB);
            PG8_BAR; PG8_WAIT_L(0); PG8_MMA(0, 1, At, B1); PG8_BAR;
            PG8_LDA(At, 0, 1); PG8_STAGE(PG8_SA(0, 0), a2, voffA);
            PG8_BAR; PG8_WAIT_L(0); PG8_MMA(1, 0, At, B0); PG8_BAR; PG8_SCHED;
            PG8_STAGE(PG8_SB(0, 1), b2 + hstepB, voffB);
            PG8_WAIT_V(6); PG8_BAR; PG8_MMA(1, 1, At, B1); PG8_BAR;
            PG8_LDB(B0, 1, 0); PG8_SCHED; PG8_LDA(At, 1, 0); PG8_STAGE(PG8_SA(0, 1), a2 + hstepA, voffA);
            PG8_WAIT_L(8); PG8_BAR; PG8_WAIT_L(0); PG8_MMA(0, 0, At, B0); PG8_BAR; PG8_SCHED;
            PG8_LDB(B1, 1, 1); PG8_STAGE(PG8_SB(1, 0), b3, voffB);
            PG8_BAR; PG8_WAIT_L(0); PG8_MMA(0, 1, At, B1); PG8_BAR;
            PG8_LDA(At, 1, 1); PG8_STAGE(PG8_SA(1, 0), a3, voffA);
            PG8_BAR; PG8_WAIT_L(0); PG8_MMA(1, 0, At, B0); PG8_BAR; PG8_SCHED;
            PG8_STAGE(PG8_SB(1, 1), b3 + hstepB, voffB);
            PG8_WAIT_V(6); PG8_BAR; PG8_MMA(1, 1, At, B1); PG8_BAR;
            }
        }
        if constexpr (ALIGN_EPI) { if (wr == 0) PG8_BAR; }
        if constexpr (!Epi::AFTER_DRAIN) { E(acc, cur, wr, wc, fr, fq); S.done(cur); }
        if (!has_next) break;
#pragma unroll
        for (int a = 0; a < 2; ++a)
#pragma unroll
            for (int b = 0; b < 2; ++b)
#pragma unroll
                for (int m = 0; m < 4; ++m)
#pragma unroll
                    for (int n = 0; n < 2; ++n) acc[a][b][m][n] = pg8_zero4<acc_t>();
        cur = nxt; cA = nA; cB = nB; ++ui;
        if constexpr (ALIGN_EPI) { if (wr == 1) PG8_BAR; }
    }
    PG8_WAIT_V(0);
    if constexpr (!ALIGN_EPI) { if (wr == 0) PG8_BAR; }
    PG8_BAR;
    if constexpr (Epi::AFTER_DRAIN) { E.fused(acc, cur, wr, wc, fr, fq, lds, wid, lane); S.done(cur); }
#undef PG8_AOFF
#undef PG8_SA
#undef PG8_SB
#undef PG8_STAGE
#undef PG8_LDA
#undef PG8_LDB
#undef PG8_MMA
#undef PG8_WAIT_V
#undef PG8_WAIT_L
#undef PG8_BAR
#undef PG8_SCHED
}
}

#define GAS __attribute__((address_space(1)))
#define LAS __attribute__((address_space(3)))
typedef unsigned short bf16;
typedef unsigned v4u __attribute__((ext_vector_type(4)));
typedef float f32x4 __attribute__((ext_vector_type(4)));
typedef short bf16x8 __attribute__((ext_vector_type(8)));
typedef GAS unsigned gu32;
typedef GAS unsigned long long gu64;
#define RLX_AGENT __ATOMIC_RELAXED, __HIP_MEMORY_SCOPE_AGENT
#define LDS_WAIT() asm volatile("s_waitcnt lgkmcnt(0)" ::: "memory")
#define VM_WAIT() asm volatile("s_waitcnt vmcnt(0)" ::: "memory")
__device__ __forceinline__ unsigned long long rt() { return __builtin_amdgcn_s_memrealtime(); }
__device__ __forceinline__ unsigned f2bf(float f) { unsigned u = __builtin_bit_cast(unsigned, f); return (u + 0x7fffu + ((u >> 16) & 1u)) >> 16; }
__device__ __forceinline__ unsigned pk2(float lo, float hi) { return f2bf(lo) | (f2bf(hi) << 16); }

#define XB_TMO      128
#define XB_XCNT(j)  (256  + 64 * (j))
#define XB_XSUB(j)  (1280 + 64 * (j))
#define XB_XGEN(j)  (2304 + 64 * (j))
#define XB_TOP      3328
#define XB_TOPGEN   3392
#define XCD_BAR_WORDS 3456
#define XB_SPIN_CAP (1u << 18)

__device__ __forceinline__ unsigned xb_ld(unsigned* p)              { return __hip_atomic_load(p, __ATOMIC_RELAXED, __HIP_MEMORY_SCOPE_AGENT); }
__device__ __forceinline__ unsigned xb_add(unsigned* p, unsigned v) { return __hip_atomic_fetch_add(p, v, __ATOMIC_RELAXED, __HIP_MEMORY_SCOPE_AGENT); }
__device__ __forceinline__ unsigned xb_xcc_id() { return (unsigned)__builtin_amdgcn_s_getreg((3 << 11) | 20) & 0xFu; }
#define XB_SPIN(cond, bar) do { unsigned _sp = 0; while (cond) { __builtin_amdgcn_s_sleep(1); \
    if ((++_sp & 255u) == 0u) { if (xb_ld(&(bar)[XB_TMO])) break; if (_sp > XB_SPIN_CAP) { atomicAdd(&(bar)[XB_TMO], 1u); break; } } } } while (0)

struct XcdBarrier {
    unsigned* bar; unsigned x;
    volatile LAS unsigned* st;
};

__device__ __forceinline__ XcdBarrier xcd_barrier_post(unsigned* bar, volatile LAS unsigned* st) {
    XcdBarrier b; b.bar = bar; b.x = xb_xcc_id(); b.st = st;
    if (threadIdx.x == 0) (void)xb_add(&bar[XB_XCNT(b.x)], 1u);
    return b;
}
__device__ __forceinline__ void xcd_barrier_complete(unsigned* bar, unsigned x, unsigned& nloc, unsigned& nx) {
    const unsigned G = gridDim.x * gridDim.y * gridDim.z;
    unsigned sum, cnt, mine, sp = 0u;
    for (;;) {
        sum = 0u; cnt = 0u; mine = 0u;
#pragma unroll 1
        for (unsigned j = 0; j < 16; ++j) { const unsigned c = xb_ld(&bar[XB_XCNT(j)]); sum += c; cnt += (c > 0u) ? 1u : 0u; mine = (j == x) ? c : mine; }
        if (sum == G) break;
        __builtin_amdgcn_s_sleep(1);
        if ((++sp & 255u) == 0u) { if (xb_ld(&bar[XB_TMO])) break; if (sp > XB_SPIN_CAP) { atomicAdd(&bar[XB_TMO], 1u); break; } }
    }
    nloc = mine > 0u ? mine : 1u; nx = cnt > 0u ? cnt : 1u;
}

__device__ __forceinline__ void xcd_barrier(const XcdBarrier& b) {
    asm volatile("s_waitcnt vmcnt(0)" ::: "memory");
    __syncthreads();
    if (threadIdx.x == 0) {
        unsigned* bar = b.bar;
        __builtin_amdgcn_s_waitcnt(0);
        unsigned nloc = b.st[0], nx = b.st[1];
        if (nloc == 0u) { xcd_barrier_complete(bar, b.x, nloc, nx); b.st[0] = nloc; b.st[1] = nx; }
        const unsigned old = xb_add(&bar[XB_XSUB(b.x)], 1u);
        const unsigned gen = old / nloc;
        if (old + 1u == (gen + 1u) * nloc) {
            __builtin_amdgcn_fence(__ATOMIC_RELEASE, "agent");
            asm volatile("s_waitcnt vmcnt(0)" ::: "memory");
            const unsigned og = xb_add(&bar[XB_TOP], 1u);
            const unsigned tg = og / nx;
            if (og + 1u == (tg + 1u) * nx) xb_add(&bar[XB_TOPGEN], 1u);
            else XB_SPIN(xb_ld(&bar[XB_TOPGEN]) == tg, bar);
            __builtin_amdgcn_fence(__ATOMIC_ACQUIRE, "agent");
            xb_add(&bar[XB_XGEN(b.x)], 1u);
            asm volatile("s_waitcnt vmcnt(0)" ::: "memory");
        } else {
            XB_SPIN(xb_ld(&bar[XB_XGEN(b.x)]) == gen, bar);
            __builtin_amdgcn_fence(__ATOMIC_ACQUIRE, "agent");
            asm volatile("s_waitcnt vmcnt(0)" ::: "memory");
        }
    }
    __syncthreads();
}

constexpr int NWAVES = 8;
constexpr int NB = 16, SEQ = 2048, DM = 1024, MTOK = NB * SEQ, DEPTH = 4;
constexpr int P_IN = 2988, NPROJ = 3072, DFF = 2816, NUP = 2 * DFF, CHROWS = MTOK / 2;
constexpr float RMS_EPS = 1e-6f;
#ifndef MK_N_LAUNCHES
#define MK_N_LAUNCHES 1
#endif
#ifndef PROBE_MASK
#define PROBE_MASK 0
#endif
constexpr int NP = 11;
constexpr int NPH = DEPTH * NP + 1;

constexpr size_t MiB = 1u << 20;
constexpr size_t WS_CTL = 0, CTL_ZERO_BYTES = 1 * MiB;
constexpr size_t WS_WIN = 1 * MiB, WS_WG = 7 * MiB, WS_WB = 15 * MiB, WS_WO = 17 * MiB, WS_WUP = 19 * MiB, WS_WD = 30 * MiB;
constexpr size_t WS_MASK = 36 * MiB;
constexpr size_t WS_CUM = 44 * MiB;
constexpr size_t WS_KMEAN = 45 * MiB;
constexpr size_t WS_SSA = 46 * MiB, WS_SSB = 47 * MiB;
constexpr size_t WS_WALT = 47 * MiB;
constexpr size_t WS_PQ = 112 * MiB, WS_PK = 176 * MiB, WS_PV = 240 * MiB;
constexpr size_t WS_MIX = 112 * MiB;
constexpr size_t WS_XB = 432 * MiB;
constexpr size_t WS_BV = 176 * MiB;
constexpr size_t WS_HALO = 112 * MiB;
constexpr size_t WS_ACT = 144 * MiB;
constexpr size_t WS_PARTA = 496 * MiB, WS_PARTB = 498 * MiB;
constexpr size_t WS_X8 = 320 * MiB;
constexpr size_t WS_X18 = 352 * MiB;
constexpr size_t WS_SX = 384 * MiB, WS_SX1 = 385 * MiB;
constexpr size_t WS_WIN8 = 401 * MiB;
constexpr size_t WS_SWIN = 405 * MiB;
constexpr size_t WS_CMAXI = 256 * 1024;
constexpr size_t WS_SSA1 = 399 * MiB, WS_SSB1 = 400 * MiB;
constexpr size_t WS_WG8 = 386 * MiB;
constexpr size_t WS_WUP8 = 392 * MiB;
constexpr size_t WS_CMAXU = 128 * 1024;
constexpr size_t WS_END = 500 * MiB;
static_assert(WS_BV + (size_t)MTOK * 4096 * 2 <= WS_XB && WS_HALO + (size_t)(MTOK / 64) * 4 * NUP * 2 <= WS_ACT && WS_ACT + (size_t)MTOK * DFF * 2 <= WS_XB && WS_XB + (size_t)MTOK * 1024 * 2 <= WS_END, "ws map");
constexpr int CW_TMO = 0, CW_CODE = 1, CW_BAR = 4096, CW_WMAXG = 16384, CW_WMAXU = 16400;

constexpr int RING_OFF = 0, RING_BYTES = 131072;
constexpr int AUX_OFF = 131072;
constexpr int AUXW_OFF = AUX_OFF + 16384;
constexpr int LUT_OFF = AUXW_OFF + 512, LUT_STRIDE = 132;
constexpr int LUT2_OFF = LUT_OFF + 8 * LUT_STRIDE * 4;
constexpr int LDSCTL_OFF = LUT2_OFF + 8 * LUT_STRIDE * 4, MISC_OFF = LDSCTL_OFF + 64;
constexpr int LDS_BYTES = 159744;
static_assert(MISC_OFF + 128 <= LDS_BYTES, "LDS map");

struct Args { const float* in[14]; float* out; unsigned char* ws; int g_lo, g_hi, li, pad; };
struct Frame {
    LAS unsigned char* lds;
    volatile LAS unsigned* MISC;
    unsigned char* ws;
    int tid, lane, wave;
    int vcu, G;
};
typedef __attribute__((address_space(4))) const Args CArgs;
__device__ __forceinline__ const float* inp(int i) { CArgs* p = (CArgs*)__builtin_amdgcn_kernarg_segment_ptr(); asm volatile("" : "+s"(p)); return p->in[i]; }
__device__ __forceinline__ float* outp() { CArgs* p = (CArgs*)__builtin_amdgcn_kernarg_segment_ptr(); asm volatile("" : "+s"(p)); return p->out; }
#define F_CTL ((gu32*)(F.ws + WS_CTL))
#define F_WinT ((bf16*)(F.ws + WS_WIN + wofs))
#define F_WgT ((bf16*)(F.ws + WS_WG + wofs))
#define F_WbT ((bf16*)(F.ws + WS_WB + wofs))
#define F_WoT ((bf16*)(F.ws + WS_WO + wofs))
#define F_WupT ((bf16*)(F.ws + WS_WUP + wofs))
#define F_WdT ((bf16*)(F.ws + WS_WD + wofs))
#define F_PQ ((bf16*)(F.ws + WS_PQ))
#define F_PK ((bf16*)(F.ws + WS_PK))
#define F_PV ((bf16*)(F.ws + WS_PV))
#define F_MIX ((bf16*)(F.ws + WS_MIX))
#define F_XB ((bf16*)(F.ws + WS_XB))
#define F_BV ((bf16*)(F.ws + WS_BV))
#define F_BVQ ((unsigned char*)(F.ws + WS_BV))
#define F_X8 ((unsigned char*)(F.ws + WS_X8))
#define F_X18 ((unsigned char*)(F.ws + WS_X18))
#define F_SX ((float*)(F.ws + WS_SX))
#define F_SX1 ((float*)(F.ws + WS_SX1))
#define F_SSA1 ((float*)(F.ws + WS_SSA1))
#define F_SSB1 ((float*)(F.ws + WS_SSB1))
#define F_WG8 ((unsigned char*)(F.ws + WS_WG8))
#define F_WUP8 ((unsigned char*)(F.ws + WS_WUP8))
#define F_CMAXU ((float*)(F.ws + WS_CMAXU))
#define F_CMAXI ((float*)(F.ws + WS_CMAXI))
#define F_WIN8 ((unsigned char*)(F.ws + WS_WIN8))
#define F_SWIN ((float*)(F.ws + WS_SWIN))
#define F_HALO ((bf16*)(F.ws + WS_HALO))
#define F_ACT ((bf16*)(F.ws + WS_ACT))
#define F_MASK ((unsigned long long*)(F.ws + WS_MASK))
#define F_CUM ((float*)(F.ws + WS_CUM))
#define F_KMEAN ((float*)(F.ws + WS_KMEAN))
#define F_SSA ((float*)(F.ws + WS_SSA))
#define F_SSB ((float*)(F.ws + WS_SSB))
#define F_PARTA ((float*)(F.ws + WS_PARTA))
#define F_PARTB ((float*)(F.ws + WS_PARTB))
__device__ __forceinline__ float shx(float v, int lane, int mask) { return __builtin_bit_cast(float, __builtin_amdgcn_ds_bpermute((lane ^ mask) << 2, __builtin_bit_cast(int, v))); }
__device__ __forceinline__ float wave_sum(float v, int lane) {
#pragma unroll
    for (int o = 1; o < 64; o <<= 1) v += shx(v, lane, o);
    return v;
}
__device__ __forceinline__ float bf2f(unsigned short b) { return __uint_as_float((unsigned)b << 16); }
__device__ __forceinline__ float bflo(unsigned w) { return __uint_as_float(w << 16); }
__device__ __forceinline__ float bfhi(unsigned w) { return __uint_as_float(w & 0xffff0000u); }
template <class T> __device__ __forceinline__ T* vptr(T* p) { asm volatile("" : "+v"(p)); return p; }

__device__ __forceinline__ long proj_src_col(int n) {
    const int t = n >> 10, c = n & 1023;
    if (t == 0) { const int s = c >> 8, r = c & 255; return (s == 0 ? 0 : s == 1 ? 768 : s == 2 ? 1536 : 2308) + r; }
    if (t == 2) { const int s = c >> 8, r = c & 255; return (s == 0 ? 512 : s == 1 ? 1280 : s == 2 ? 2048 : 2692) + r; }
    if (c < 768) { const int s = c >> 8, r = c & 255; return (s == 0 ? 256 : s == 1 ? 1024 : 1792) + r; }
    if (c < 832) return 2564 + (c - 768);
    if (c < 896) return 2628 + (c - 832);
    if (c < 928) return 2948 + (c - 896);
    if (c < 936) return 2980 + (c - 928);
    if (c < 940) return 2304 + (c - 936);
    return -1;
}
struct MapProj { __device__ __forceinline__ long operator()(int n) const { return proj_src_col(n); } };
struct MapId { __device__ __forceinline__ long operator()(int n) const { return n; } };
struct MapGate { __device__ __forceinline__ long operator()(int R) const { const int pn = R >> 8, c = R & 255, bj = c >> 7, wc = (c >> 5) & 3, nn = (c >> 4) & 1, fq = (c >> 2) & 3, e = c & 3;
    return (long)(2 * bj + nn) * (1024L * 1024L) + 64 * pn + 16 * wc + 4 * fq + e; } };
struct MapUp { __device__ __forceinline__ long operator()(int R) const { const int pn = R >> 8, c = R & 255; return (long)(c >> 7) * DFF + 128 * pn + (c & 127); } };
struct MapBranch { __device__ __forceinline__ long operator()(int R) const { return (long)(R >> 10) * (256L * 1024L) + (R & 1023); } };
template <class Map> __device__ __forceinline__ void tr_item(const float* W, int K, int Nsrc, bf16* WT, const Map& map, LAS float* scr, int item, int nblk, int lane, const float* gk = nullptr) {
    const int kb = item / nblk, nb = item % nblk, k0 = 64 * kb, n0 = 32 * nb;
    const int kr = lane >> 3, q = lane & 7; const long so = map(n0 + 4 * q);
    f32x4 ld[8];
#pragma unroll
    for (int i = 0; i < 8; ++i) { ld[i] = so >= 0 ? *(const GAS f32x4*)(W + (size_t)so + (size_t)(k0 + kr + 8 * i) * Nsrc) : (f32x4){0.f, 0.f, 0.f, 0.f}; if (gk) ld[i] = ld[i] * gk[k0 + kr + 8 * i]; }
#pragma unroll
    for (int i = 0; i < 8; ++i) { LAS float* d = scr + (kr + 8 * i) * 33 + 4 * q; d[0] = ld[i].x; d[1] = ld[i].y; d[2] = ld[i].z; d[3] = ld[i].w; }
    LDS_WAIT(); asm volatile("" ::: "memory");
    const int c = lane & 7;
#pragma unroll
    for (int j = 0; j < 4; ++j) { const int n = (lane >> 3) + 8 * j; const LAS float* s = scr + (8 * c) * 33 + n;
        v4u o; o.x = pk2(s[0 * 33], s[1 * 33]); o.y = pk2(s[2 * 33], s[3 * 33]); o.z = pk2(s[4 * 33], s[5 * 33]); o.w = pk2(s[6 * 33], s[7 * 33]);
        *(GAS v4u*)(WT + (size_t)(n0 + n) * K + k0 + 8 * c) = o; }
    LDS_WAIT(); asm volatile("" ::: "memory");
}
__device__ __forceinline__ float wave_max(float v, int lane) {
#pragma unroll
    for (int o = 1; o < 64; o <<= 1) v = fmaxf(v, shx(v, lane, o));
    return v;
}
__device__ __forceinline__ unsigned q8x4(float a, float b, float c, float d, float inv) {
    const unsigned b0 = __float_as_uint(fmaf(a, inv, 12582912.0f)), b1 = __float_as_uint(fmaf(b, inv, 12582912.0f)), b2 = __float_as_uint(fmaf(c, inv, 12582912.0f)), b3 = __float_as_uint(fmaf(d, inv, 12582912.0f));
    return __builtin_amdgcn_perm(b1, b0, 0x0c0c0400u) | __builtin_amdgcn_perm(b3, b2, 0x04000c0cu);
}
__device__ __forceinline__ void init_row(const f32x4 (&xa)[2], const f32x4 (&xb_)[2], bf16* xb_dst, float* ssrow, unsigned char* q8row, float* sxrow, float* ss1row, int lane) {
    typedef unsigned u32x2 __attribute__((ext_vector_type(2)));
    float s = 0.f, am = 1.0e-30f; f32x4 va[2], vb[2];
#pragma unroll
    for (int j = 0; j < 2; ++j) { const int c = lane + 64 * j; const f32x4 a = xa[j], b = xb_[j];
        v4u xo; xo.x = pk2(a.x, a.y); xo.y = pk2(a.z, a.w); xo.z = pk2(b.x, b.y); xo.w = pk2(b.z, b.w); ((GAS v4u*)xb_dst)[c] = xo;
        const f32x4 ar = (f32x4){bflo(xo.x), bfhi(xo.x), bflo(xo.y), bfhi(xo.y)}, br = (f32x4){bflo(xo.z), bfhi(xo.z), bflo(xo.w), bfhi(xo.w)}; va[j] = ar; vb[j] = br;
        s += ((a.x * a.x + a.y * a.y) + (a.z * a.z + a.w * a.w)) + ((b.x * b.x + b.y * b.y) + (b.z * b.z + b.w * b.w));
        am = fmaxf(am, fmaxf(fmaxf(fabsf(ar.x), fabsf(ar.y)), fmaxf(fabsf(ar.z), fabsf(ar.w)))); am = fmaxf(am, fmaxf(fmaxf(fabsf(br.x), fabsf(br.y)), fmaxf(fabsf(br.z), fabsf(br.w)))); }
    s = wave_sum(s, lane); am = wave_max(am, lane);
    const float inv = 127.0f * __builtin_amdgcn_rcpf(am);
#pragma unroll
    for (int j = 0; j < 2; ++j) { u32x2 o; o.x = q8x4(va[j].x, va[j].y, va[j].z, va[j].w, inv); o.y = q8x4(vb[j].x, vb[j].y, vb[j].z, vb[j].w, inv); ((GAS u32x2*)q8row)[lane + 64 * j] = o; }
    if (lane == 0) { *(GAS f32x4*)ssrow = (f32x4){s, 0.f, 0.f, 0.f}; *(GAS float*)ss1row = s; *(GAS float*)sxrow = am * (1.0f / 127.0f); }
}
__device__ __forceinline__ float wmax_rows(const float* W, const float* gain, int r0, int nrows, int ncol, int lane) {
    float m = 0.f;
    for (int r = r0; r < r0 + nrows; ++r) { const float g = fabsf(gain[r & 1023]); const GAS f32x4* rp = (const GAS f32x4*)(W + (size_t)r * ncol); float mr = 0.f;
        for (int c = lane; c < ncol / 4; c += 64) { const f32x4 v = rp[c]; mr = fmaxf(fmaxf(mr, fabsf(v.x)), fmaxf(fabsf(v.y), fmaxf(fabsf(v.z), fabsf(v.w)))); }
        m = fmaxf(m, mr * g); }
    return wave_max(m, lane);
}
__device__ __forceinline__ void p_wmax(Frame& F) {
    const int gw = F.vcu * NWAVES + F.wave, NGW = F.G * NWAVES, lane = F.lane;
    for (int it = gw; it < DEPTH * 512; it += NGW) { const int l = it >> 9; const float m = wmax_rows(inp(7) + (size_t)l * 4 * DM * DM, inp(1) + l * DM, (it & 511) * 8, 8, DM, lane);
        if (lane == 0) __hip_atomic_fetch_max((unsigned*)(F_CTL + CW_WMAXG + l), __float_as_uint(m), __ATOMIC_RELAXED, __HIP_MEMORY_SCOPE_AGENT); }
    for (int it = gw; it < DEPTH * 47 * 4; it += NGW) { const int l = it / (47 * 4), rem = it % (47 * 4), strip = rem >> 2, kq = rem & 3; const int c0 = strip * 64 + 4 * (lane & 15);
        if (c0 < P_IN) {
            const float* W = inp(4) + (size_t)l * DM * P_IN + c0; const GAS float* gain = (const GAS float*)(inp(1) + l * DM);
            f32x4 m = (f32x4){0.f, 0.f, 0.f, 0.f};
#pragma unroll 8
            for (int k = kq * 256 + (lane >> 4); k < kq * 256 + 256; k += 4) { const f32x4 v = *(const GAS f32x4*)(W + (size_t)k * P_IN); const float g = fabsf(gain[k]);
                m.x = fmaxf(m.x, fabsf(v.x) * g); m.y = fmaxf(m.y, fabsf(v.y) * g); m.z = fmaxf(m.z, fabsf(v.z) * g); m.w = fmaxf(m.w, fabsf(v.w) * g); }
            m.x = fmaxf(m.x, shx(m.x, lane, 16)); m.y = fmaxf(m.y, shx(m.y, lane, 16)); m.z = fmaxf(m.z, shx(m.z, lane, 16)); m.w = fmaxf(m.w, shx(m.w, lane, 16));
            m.x = fmaxf(m.x, shx(m.x, lane, 32)); m.y = fmaxf(m.y, shx(m.y, lane, 32)); m.z = fmaxf(m.z, shx(m.z, lane, 32)); m.w = fmaxf(m.w, shx(m.w, lane, 32));
            unsigned* cp = (unsigned*)(F_CMAXI + (size_t)l * 3008 + c0);
            if (lane < 16) { __hip_atomic_fetch_max(cp, __float_as_uint(m.x), __ATOMIC_RELAXED, __HIP_MEMORY_SCOPE_AGENT); __hip_atomic_fetch_max(cp + 1, __float_as_uint(m.y), __ATOMIC_RELAXED, __HIP_MEMORY_SCOPE_AGENT);
            __hip_atomic_fetch_max(cp + 2, __float_as_uint(m.z), __ATOMIC_RELAXED, __HIP_MEMORY_SCOPE_AGENT); __hip_atomic_fetch_max(cp + 3, __float_as_uint(m.w), __ATOMIC_RELAXED, __HIP_MEMORY_SCOPE_AGENT); } } }
    for (int it = gw; it < DEPTH * (NUP / 64) * 4; it += NGW) { const int l = it / ((NUP / 64) * 4), rem = it % ((NUP / 64) * 4), strip = rem >> 2, kq = rem & 3;
        const float* W = inp(10) + (size_t)l * DM * NUP + strip * 64 + 4 * (lane & 15); const GAS float* gain = (const GAS float*)(inp(2) + l * DM);
        f32x4 m = (f32x4){0.f, 0.f, 0.f, 0.f};
#pragma unroll 8
        for (int k = kq * 256 + (lane >> 4); k < kq * 256 + 256; k += 4) { const f32x4 v = *(const GAS f32x4*)(W + (size_t)k * NUP); const float g = fabsf(gain[k]);
            m.x = fmaxf(m.x, fabsf(v.x) * g); m.y = fmaxf(m.y, fabsf(v.y) * g); m.z = fmaxf(m.z, fabsf(v.z) * g); m.w = fmaxf(m.w, fabsf(v.w) * g); }
        m.x = fmaxf(m.x, shx(m.x, lane, 16)); m.y = fmaxf(m.y, shx(m.y, lane, 16)); m.z = fmaxf(m.z, shx(m.z, lane, 16)); m.w = fmaxf(m.w, shx(m.w, lane, 16));
        m.x = fmaxf(m.x, shx(m.x, lane, 32)); m.y = fmaxf(m.y, shx(m.y, lane, 32)); m.z = fmaxf(m.z, shx(m.z, lane, 32)); m.w = fmaxf(m.w, shx(m.w, lane, 32));
        if (lane < 16) { unsigned* cp = (unsigned*)(F_CMAXU + (size_t)l * NUP + strip * 64 + 4 * lane);
            __hip_atomic_fetch_max(cp, __float_as_uint(m.x), __ATOMIC_RELAXED, __HIP_MEMORY_SCOPE_AGENT); __hip_atomic_fetch_max(cp + 1, __float_as_uint(m.y), __ATOMIC_RELAXED, __HIP_MEMORY_SCOPE_AGENT);
            __hip_atomic_fetch_max(cp + 2, __float_as_uint(m.z), __ATOMIC_RELAXED, __HIP_MEMORY_SCOPE_AGENT); __hip_atomic_fetch_max(cp + 3, __float_as_uint(m.w), __ATOMIC_RELAXED, __HIP_MEMORY_SCOPE_AGENT); } }
}
template <class Map> __device__ __forceinline__ void tr_item8(const float* W, int K, int Nsrc, unsigned char* WT8, const Map& map, LAS float* scr, int item, int nblk, int lane, const float* gk, float inv, const float* cmax = nullptr, float* swout = nullptr) {
    typedef unsigned u32x2 __attribute__((ext_vector_type(2)));
    const int kb = item / nblk, nb = item % nblk, k0 = 64 * kb, n0 = 32 * nb;
    const int kr = lane >> 3, q = lane & 7; const long so = map(n0 + 4 * q);
    f32x4 ld[8]; f32x4 inv4 = (f32x4){inv, inv, inv, inv};
    if (cmax) { const f32x4 c4 = so >= 0 ? *(const GAS f32x4*)(cmax + so) : (f32x4){0.f, 0.f, 0.f, 0.f};
        if (swout && kb == 0 && kr == 0) *(GAS f32x4*)(swout + n0 + 4 * q) = c4 * (1.0f / 127.0f);
        inv4 = (f32x4){127.0f / fmaxf(c4.x, 1.0e-30f), 127.0f / fmaxf(c4.y, 1.0e-30f), 127.0f / fmaxf(c4.z, 1.0e-30f), 127.0f / fmaxf(c4.w, 1.0e-30f)}; }
#pragma unroll
    for (int i = 0; i < 8; ++i) { ld[i] = so >= 0 ? *(const GAS f32x4*)(W + (size_t)so + (size_t)(k0 + kr + 8 * i) * Nsrc) : (f32x4){0.f, 0.f, 0.f, 0.f}; ld[i] = ld[i] * gk[k0 + kr + 8 * i] * inv4; }
#pragma unroll
    for (int i = 0; i < 8; ++i) { LAS float* d = scr + (kr + 8 * i) * 33 + 4 * q; d[0] = ld[i].x; d[1] = ld[i].y; d[2] = ld[i].z; d[3] = ld[i].w; }
    LDS_WAIT(); asm volatile("" ::: "memory");
    const int c = lane & 7;
#pragma unroll
    for (int j = 0; j < 4; ++j) { const int n = (lane >> 3) + 8 * j; const LAS float* s = scr + (8 * c) * 33 + n;
        u32x2 o; o.x = q8x4(s[0 * 33], s[1 * 33], s[2 * 33], s[3 * 33], 1.0f); o.y = q8x4(s[4 * 33], s[5 * 33], s[6 * 33], s[7 * 33], 1.0f);
        *(GAS u32x2*)(WT8 + (size_t)(n0 + n) * K + k0 + 8 * c) = o; }
    LDS_WAIT(); asm volatile("" ::: "memory");
}
template <int NR> __device__ __forceinline__ void quant_rows(const bf16* xb, unsigned char* q8, float* sxv, const float* ss4, float* ss1, int m0, int mstride, int lane) {
    typedef unsigned u32x2 __attribute__((ext_vector_type(2)));
    v4u t[NR][2];
#pragma unroll
    for (int r = 0; r < NR; ++r)
#pragma unroll
        for (int j = 0; j < 2; ++j) t[r][j] = ((const GAS v4u*)(xb + (size_t)min(m0 + r * mstride, MTOK - 1) * DM))[lane + 64 * j];
#pragma unroll
    for (int r = 0; r < NR; ++r) { const int m = m0 + r * mstride; if (m >= MTOK) break;
        float v[16]; float am = 1.0e-30f;
#pragma unroll
        for (int j = 0; j < 2; ++j) { const v4u tt = t[r][j];
            v[8 * j] = bflo(tt.x); v[8 * j + 1] = bfhi(tt.x); v[8 * j + 2] = bflo(tt.y); v[8 * j + 3] = bfhi(tt.y); v[8 * j + 4] = bflo(tt.z); v[8 * j + 5] = bfhi(tt.z); v[8 * j + 6] = bflo(tt.w); v[8 * j + 7] = bfhi(tt.w); }
#pragma unroll
        for (int j = 0; j < 16; ++j) am = fmaxf(am, fabsf(v[j]));
        am = wave_max(am, lane);
        const float inv = 127.0f * __builtin_amdgcn_rcpf(am);
#pragma unroll
        for (int j = 0; j < 2; ++j) { u32x2 o; o.x = q8x4(v[8 * j], v[8 * j + 1], v[8 * j + 2], v[8 * j + 3], inv); o.y = q8x4(v[8 * j + 4], v[8 * j + 5], v[8 * j + 6], v[8 * j + 7], inv);
            ((GAS u32x2*)(q8 + (size_t)m * DM))[lane + 64 * j] = o; }
        if (lane == 0) { *(GAS float*)(sxv + m) = am * (1.0f / 127.0f); const f32x4 p4 = *(const GAS f32x4*)(ss4 + 4 * (size_t)m); *(GAS float*)(ss1 + m) = (p4.x + p4.y) + (p4.z + p4.w); } }
}
__device__ __forceinline__ void p_quant(Frame& F, int l) {
    LAS float* scr = (LAS float*)(F.lds + RING_OFF + F.wave * 16384);
    const int gw = F.vcu * NWAVES + F.wave, NGW = F.G * NWAVES;
    {   const float wm = fmaxf(__uint_as_float(*vptr((const GAS unsigned*)(F_CTL + CW_WMAXG + l))), 1.0e-30f); const float inv = 127.0f / wm;
        const float* w_gate = inp(7) + (size_t)l * 4 * DM * DM; const float* gmix = inp(1) + l * DM;
        for (int it = gw; it < 16 * 128; it += NGW) tr_item8(w_gate, DM, DM, F_WG8, MapGate(), scr, it, 128, F.lane, gmix, inv); }
    {   const float* w_up = inp(10) + (size_t)l * DM * NUP; const float* gffn = inp(2) + l * DM;
        for (int it = gw; it < 16 * 176; it += NGW) tr_item8(w_up, DM, NUP, F_WUP8, MapUp(), scr, it, 176, F.lane, gffn, 1.0f, F_CMAXU + (size_t)l * NUP); }
}
__device__ __forceinline__ void p_quant0(Frame& F) {
    const int gw = F.vcu * NWAVES + F.wave, NGW = F.G * NWAVES;
    for (int m = gw; m < MTOK; m += 16 * NGW) quant_rows<16>(F_XB, F_X8, F_SX, F_SSA, F_SSA1, m, NGW, F.lane);
}
__device__ __forceinline__ void p_quant1(Frame& F) {
    const int gw = F.vcu * NWAVES + F.wave, NGW = F.G * NWAVES;
    for (int m = gw; m < MTOK; m += 16 * NGW) quant_rows<16>(F_XB, F_X18, F_SX1, F_SSB, F_SSB1, m, NGW, F.lane);
}
__device__ __forceinline__ void p_wconv(Frame& F, int l, const size_t wofs) {
    LAS float* scr = (LAS float*)(F.lds + RING_OFF + F.wave * 16384);
    const int gw = F.vcu * NWAVES + F.wave, NGW = F.G * NWAVES;
    constexpr int I_WIN = 16 * 96, I_WG = 0  , I_WB = 4 * 128, I_WO = 16 * 32, I_WUP = 0  , I_WD = 44 * 32;
    constexpr int NITEMS = I_WIN + I_WG + I_WB + I_WO + I_WUP + I_WD;
    const float* w_in = inp(4) + (size_t)l * DM * P_IN; const float* w_gate = inp(7) + (size_t)l * 4 * DM * DM; const float* w_branch = inp(8) + (size_t)l * 4 * 256 * DM;
    const float* w_out = inp(9) + (size_t)l * DM * DM; const float* w_up = inp(10) + (size_t)l * DM * NUP; const float* w_down = inp(13) + (size_t)l * DFF * DM;
    const float* gmix = inp(1) + l * DM; const float* gffn = inp(2) + l * DM;
    for (int it = gw; it < NITEMS; it += NGW) {
        int r = it;
        if (r < I_WIN) { tr_item8(w_in, DM, P_IN, F_WIN8, MapProj(), scr, r, 96, F.lane, gmix, 1.0f, F_CMAXI + (size_t)l * 3008, F_SWIN); continue; } r -= I_WIN;
        if (r < I_WG) { tr_item(w_gate, DM, DM, F_WgT, MapGate(), scr, r, 128, F.lane, gmix); continue; } r -= I_WG;
        if (r < I_WB) { tr_item(w_branch, 256, DM, F_WbT, MapBranch(), scr, r, 128, F.lane); continue; } r -= I_WB;
        if (r < I_WO) { tr_item(w_out, DM, DM, F_WoT, MapId(), scr, r, 32, F.lane); continue; } r -= I_WO;
        if (r < I_WUP) { tr_item(w_up, DM, NUP, F_WupT, MapUp(), scr, r, 176, F.lane, gffn); continue; } r -= I_WUP;
        tr_item(w_down, DFF, DM, F_WdT, MapId(), scr, r, 32, F.lane);
    }
}
__device__ __forceinline__ void p_init(Frame& F) {
    const int gw = F.vcu * NWAVES + F.wave, NGW = F.G * NWAVES; const float* x = inp(0);
    for (int m0 = gw; m0 < MTOK; m0 += 4 * NGW) {
        f32x4 xa[4][2], xb_[4][2];
#pragma unroll
        for (int r = 0; r < 4; ++r)
#pragma unroll
            for (int j = 0; j < 2; ++j) { const GAS f32x4* xr = (const GAS f32x4*)(x + (size_t)min(m0 + r * NGW, MTOK - 1) * DM) + 2 * (F.lane + 64 * j); xa[r][j] = xr[0]; xb_[r][j] = xr[1]; }
#pragma unroll
        for (int r = 0; r < 4; ++r) { const int m = m0 + r * NGW; if (m >= MTOK) break;
            init_row(xa[r], xb_[r], F_XB + (size_t)m * DM, F_SSA + 4 * (size_t)m, F_X8 + (size_t)m * DM, F_SX + m, F_SSA1 + m, F.lane); } }
}
__device__ __forceinline__ void zero_u64(Frame& F, unsigned long long* p, int n) {
    const int gt = (F.vcu * NWAVES + F.wave) * 64 + F.lane, NT = F.G * NWAVES * 64; unsigned z = 0u; asm volatile("" : "+v"(z));
    for (int i = gt; i < n / 2; i += NT) ((GAS v4u*)p)[i] = (v4u){z, z, z, z};
}
__device__ __forceinline__ void p_final(Frame& F, float* out, const float* gain) {
    const int gw = F.vcu * NWAVES + F.wave, NGW = F.G * NWAVES, lane = F.lane;
    f32x4 ga[2], gb[2];
#pragma unroll
    for (int j = 0; j < 2; ++j) { const GAS f32x4* gr = (const GAS f32x4*)gain + 2 * (lane + 64 * j); ga[j] = gr[0]; gb[j] = gr[1]; }
    for (int m0 = gw; m0 < MTOK; m0 += 4 * NGW) {
        v4u t[4][2];
#pragma unroll
        for (int r = 0; r < 4; ++r)
#pragma unroll
            for (int j = 0; j < 2; ++j) t[r][j] = ((const GAS v4u*)(F_XB + (size_t)min(m0 + r * NGW, MTOK - 1) * DM))[lane + 64 * j];
#pragma unroll
        for (int r = 0; r < 4; ++r) { const int m = m0 + r * NGW; if (m >= MTOK) break;
            float v[16]; float s = 0.f;
#pragma unroll
            for (int j = 0; j < 2; ++j) { const v4u tt = t[r][j];
                v[8 * j] = bflo(tt.x); v[8 * j + 1] = bfhi(tt.x); v[8 * j + 2] = bflo(tt.y); v[8 * j + 3] = bfhi(tt.y); v[8 * j + 4] = bflo(tt.z); v[8 * j + 5] = bfhi(tt.z); v[8 * j + 6] = bflo(tt.w); v[8 * j + 7] = bfhi(tt.w); }
#pragma unroll
            for (int j = 0; j < 16; ++j) s += v[j] * v[j];
            const float rstd = 1.0f / sqrtf(wave_sum(s, lane) * (1.f / DM) + RMS_EPS);
#pragma unroll
            for (int j = 0; j < 2; ++j) { GAS f32x4* op = (GAS f32x4*)(out + (size_t)m * DM) + 2 * (lane + 64 * j);
                op[0] = (f32x4){v[8 * j] * rstd * ga[j].x, v[8 * j + 1] * rstd * ga[j].y, v[8 * j + 2] * rstd * ga[j].z, v[8 * j + 3] * rstd * ga[j].w};
                op[1] = (f32x4){v[8 * j + 4] * rstd * gb[j].x, v[8 * j + 5] * rstd * gb[j].y, v[8 * j + 6] * rstd * gb[j].z, v[8 * j + 7] * rstd * gb[j].w}; } }
    }
}


namespace att {
typedef float f32x16 __attribute__((ext_vector_type(16)));
typedef short s16x4 __attribute__((ext_vector_type(4)));
typedef short bf16x8 __attribute__((ext_vector_type(8)));
typedef float f32x2_t __attribute__((ext_vector_type(2)));
typedef __bf16 bf16x2_t __attribute__((ext_vector_type(2)));
typedef unsigned u32x4_t __attribute__((ext_vector_type(4)));
__device__ __forceinline__ int crow(int r, int hi) { return (r & 3) + 8 * (r >> 2) + 4 * hi; }
constexpr int KS = 144, TILE_B = 64 * KS;
constexpr int L_K = 0, L_V = 2 * TILE_B, L_C = 4 * TILE_B, L_FLAG = L_C + 512;
constexpr float SB_DONE = -160.0f;
constexpr float FOX_SKIP = -300.0f;
constexpr float LOG2E = 1.4426950408889634f, SC2 = 0.125f * LOG2E;
__device__ __forceinline__ unsigned cvtpk(float lo, float hi) { f32x2_t v = {lo, hi}; bf16x2_t b = __builtin_convertvector(v, bf16x2_t); return __builtin_bit_cast(unsigned, b); }
__device__ __forceinline__ float xhalf_sum(float x) { auto rr = __builtin_amdgcn_permlane32_swap(__float_as_uint(x), __float_as_uint(x), false, false); return __uint_as_float(rr[0]) + __uint_as_float(rr[1]); }
__device__ __forceinline__ float xhalf_max(float x) { auto rr = __builtin_amdgcn_permlane32_swap(__float_as_uint(x), __float_as_uint(x), false, false); return fmaxf(__uint_as_float(rr[0]), __uint_as_float(rr[1])); }
__device__ __forceinline__ bf16x8 pack8(const f32x16& p, int s) {
    u32x4_t w; w.x = cvtpk(p[8 * s + 0], p[8 * s + 1]); w.y = cvtpk(p[8 * s + 2], p[8 * s + 3]); w.z = cvtpk(p[8 * s + 4], p[8 * s + 5]); w.w = cvtpk(p[8 * s + 6], p[8 * s + 7]);
    return __builtin_bit_cast(bf16x8, w);
}
__device__ __forceinline__ s16x4 vtr(const LAS unsigned char* p) { typedef short v4i16_t __attribute__((ext_vector_type(4))); return __builtin_bit_cast(s16x4, __builtin_amdgcn_ds_read_tr16_b64_v4i16((LAS v4i16_t*)p)); }

template <int MODE>
__device__ __forceinline__ void unit(Frame& F, int b, int head, int q0w, int nt, const bf16* Kg, const bf16* Vg, int qcol, bf16* Obase) {
    int tid_ = F.tid; asm volatile("" : "+v"(tid_));
    const int tid = tid_, lane = tid_ & 63, r32 = lane & 31, hi = lane >> 5;
    LAS unsigned char* L = F.lds + RING_OFF;
    const int tq = q0w + r32; const size_t rowq = (size_t)b * SEQ + tq;
    bf16x8 qf[4];
    {   const GAS bf16x8* qp = (const GAS bf16x8*)(F_PQ + rowq * 1024 + qcol + 8 * hi);
#pragma unroll
        for (int d0 = 0; d0 < 4; ++d0) qf[d0] = qp[2 * d0]; }
    const int tw = (q0w + 31) >> 6;
    const int srow = tid >> 3, spc = tid & 7;
    const GAS v4u* kg = (const GAS v4u*)(Kg + (size_t)srow * 1024 + spc * 8);
    const GAS v4u* vg = (const GAS v4u*)(Vg + (size_t)srow * 1024 + spc * 8);
    const int sdst = srow * KS + spc * 16;
    const GAS float* cg = (const GAS float*)F_CUM + (size_t)(b * 4 + head) * SEQ;
    const GAS unsigned long long* mrow = (const GAS unsigned long long*)F_MASK + rowq * 32;
    const LAS float* lut2 = (const LAS float*)(F.lds + LUT2_OFF) + ((MODE == 3 ? 4 : 0) + head) * LUT_STRIDE;
    f32x16 o0, o1;
#pragma unroll
    for (int r = 0; r < 16; ++r) { o0[r] = 0.f; o1[r] = 0.f; }
    float m = -1e30f, lsum = 0.f, carry = 0.f;
    float NINF = -INFINITY; asm volatile("" : "+v"(NINF));
    const int own = q0w >> 8; unsigned selbits = 0u;
    if (MODE == 1) {
        float gt[7];
#pragma unroll
        for (int n = 0; n < 7; ++n) { gt[n] = 0.f;
            if (n < own) { const GAS f32x4* kmp = vptr((const GAS f32x4*)((const GAS float*)F_KMEAN + ((size_t)((b * 4 + head) * 8 + n)) * 64)) + 2 * hi; float g = 0.f;
#pragma unroll
                for (int d0 = 0; d0 < 4; ++d0) { const f32x4 ka = kmp[4 * d0], kb = kmp[4 * d0 + 1]; const u32x4_t qw = __builtin_bit_cast(u32x4_t, qf[d0]);
                    g += bflo(qw.x) * ka.x + bfhi(qw.x) * ka.y + bflo(qw.y) * ka.z + bfhi(qw.y) * ka.w + bflo(qw.z) * kb.x + bfhi(qw.z) * kb.y + bflo(qw.w) * kb.z + bfhi(qw.w) * kb.w; }
                gt[n] = xhalf_sum(g); } }
#pragma unroll
        for (int n = 0; n < 7; ++n) if (n < own) { int rank = 0;
#pragma unroll
            for (int m2 = 0; m2 < 7; ++m2) if (m2 != n && m2 < own) rank += ((gt[m2] > gt[n]) || (gt[m2] == gt[n] && m2 < n)) ? 1 : 0;
            if (rank < 3) selbits |= 1u << n; }
    }
    float cq2 = 0.f;
    if (MODE == 2) cq2 = cg[tq] * LOG2E;
    int it0 = 0;
    if (MODE == 2) { const int q0u = q0w - 32 * F.wave; const float cq0 = cg[q0u];
        bool pred = true; if (lane < nt) pred = (cq0 - cg[64 * lane + 63]) * LOG2E >= FOX_SKIP;
        const unsigned long long bm = __ballot(pred); it0 = __builtin_ctzll(bm); if (it0 > nt - 1) it0 = nt - 1; }
    bool wdone = false;
    LAS int* flg = (LAS int*)(L + L_FLAG);
    v4u kreg, vreg; float creg = 0.f; unsigned long long mreg = 0ull;
    {   const int t = (MODE == 0) ? nt - 1 : it0;
        kreg = kg[(size_t)t * 8192]; vreg = vg[(size_t)t * 8192];
        if (MODE == 2 && tid < 64) creg = cg[64 * t + tid];
        if (MODE == 3) mreg = mrow[t < 32 ? t : 31]; }
    const int vboff = (4 * hi + ((lane & 15) >> 2)) * KS + ((lane >> 4) & 1) * 32 + (lane & 3) * 8;
#pragma unroll 1
    for (int it = it0; it < nt; ++it) {
        const int t = (MODE == 0) ? nt - 1 - it : it, buf = it & 1;
        if (MODE == 0 && lane == 0) flg[buf * 8 + F.wave] = wdone ? 1 : 0;
        *(LAS v4u*)(L + L_K + buf * TILE_B + sdst) = kreg; *(LAS v4u*)(L + L_V + buf * TILE_B + sdst) = vreg;
        if (MODE == 2 && tid < 64) ((LAS float*)(L + L_C + buf * 256))[tid] = creg * LOG2E;
        const unsigned long long mb = mreg;
        __syncthreads();
        if (it + 1 < nt) { const int tn = (MODE == 0) ? nt - 2 - it : it + 1;
            kreg = kg[(size_t)tn * 8192]; vreg = vg[(size_t)tn * 8192];
            if (MODE == 2 && tid < 64) creg = cg[64 * tn + tid];
            if (MODE == 3) mreg = mrow[tn]; }
        if (MODE == 0) { typedef int i32x4_t __attribute__((ext_vector_type(4))); const i32x4_t fa = *(const LAS i32x4_t*)(flg + buf * 8), fb = *(const LAS i32x4_t*)(flg + buf * 8 + 4);
            if ((fa.x & fa.y & fa.z & fa.w & fb.x & fb.y & fb.z & fb.w) != 0) break; }
        if (t > tw || wdone) continue;
        const bool moba_other = (MODE == 1) && ((t >> 2) != own);
        if (moba_other && __ballot((selbits >> (t >> 2)) & 1u) == 0ull) continue;
        const LAS unsigned char* Kt = L + L_K + buf * TILE_B; const LAS unsigned char* Vt = L + L_V + buf * TILE_B;
        f32x16 p0, p1;
#pragma unroll
        for (int r = 0; r < 16; ++r) { p0[r] = 0.f; p1[r] = 0.f; }
#pragma unroll
        for (int d0 = 0; d0 < 4; ++d0) {
            const bf16x8 a0 = *(const LAS bf16x8*)(Kt + r32 * KS + d0 * 32 + hi * 16);
            const bf16x8 a1 = *(const LAS bf16x8*)(Kt + (r32 + 32) * KS + d0 * 32 + hi * 16);
            p0 = __builtin_amdgcn_mfma_f32_32x32x16_bf16(a0, qf[d0], p0, 0, 0, 0);
            p1 = __builtin_amdgcn_mfma_f32_32x32x16_bf16(a1, qf[d0], p1, 0, 0, 0);
        }
        const int kbase = 64 * t;
        const bool diag = (kbase + 63 >= q0w);
        if (MODE == 0) {
            float Lv[32], Gs[8];
#pragma unroll
            for (int g = 0; g < 8; ++g) { float gs = 0.f;
#pragma unroll
                for (int i = 0; i < 4; ++i) { const int r = 4 * (g & 3) + i; const float z2 = ((g < 4) ? p0[r] : p1[r]) * SC2;
                    const float sp = fmaxf(z2, 0.f) + __builtin_amdgcn_logf(1.0f + __builtin_amdgcn_exp2f(-fabsf(z2)));
                    const int key = kbase + 8 * g + 4 * hi + i; const bool valid = !diag || (key < tq);
                    Lv[4 * g + i] = valid ? -sp : 0.f; gs += Lv[4 * g + i];
                    const float ls = valid ? (z2 - sp) : NINF;
                    if (g < 4) p0[r] = ls; else p1[r] = ls; }
                Gs[g] = gs; }
            float GP[8], T[8]; float suf = 0.f;
#pragma unroll
            for (int g = 0; g < 8; ++g) GP[g] = xhalf_sum(Gs[g]);
#pragma unroll
            for (int g = 7; g >= 0; --g) { T[g] = carry + suf + (hi == 0 ? GP[g] - Gs[g] : 0.f); suf += GP[g]; }
            carry += suf;
            wdone = (__ballot(carry > SB_DONE) == 0ull);
#pragma unroll
            for (int g = 0; g < 8; ++g) { float run = 0.f;
#pragma unroll
                for (int i = 3; i >= 0; --i) { const int r = 4 * (g & 3) + i; const float ls = (g < 4) ? p0[r] : p1[r];
                    const float w = __builtin_amdgcn_exp2f(ls + (T[g] + run)); run += Lv[4 * g + i];
                    if (g < 4) p0[r] = w; else p1[r] = w; } }
        } else if (!diag && (MODE == 2 || q0w - (kbase + 63) >= 128)) {
            typedef float f2 __attribute__((ext_vector_type(2)));
            float sub, mn;
            if (MODE == 2) {
                const LAS float* Ct = (const LAS float*)(L + L_C + buf * 256);
#pragma unroll
                for (int g = 0; g < 4; ++g) { const f32x4 ca = *(const LAS f32x4*)(Ct + 8 * g + 4 * hi), cb = *(const LAS f32x4*)(Ct + 32 + 8 * g + 4 * hi);
                    const f2 a0 = (f2){p0[4 * g], p0[4 * g + 1]} * SC2 - (f2){ca[0], ca[1]}, a1 = (f2){p0[4 * g + 2], p0[4 * g + 3]} * SC2 - (f2){ca[2], ca[3]};
                    const f2 b0 = (f2){p1[4 * g], p1[4 * g + 1]} * SC2 - (f2){cb[0], cb[1]}, b1 = (f2){p1[4 * g + 2], p1[4 * g + 3]} * SC2 - (f2){cb[2], cb[3]};
                    p0[4 * g] = a0.x; p0[4 * g + 1] = a0.y; p0[4 * g + 2] = a1.x; p0[4 * g + 3] = a1.y; p1[4 * g] = b0.x; p1[4 * g + 1] = b0.y; p1[4 * g + 2] = b1.x; p1[4 * g + 3] = b1.y; }
                float rm = fmaxf(fmaxf(p0[0], p1[0]), fmaxf(p0[1], p1[1]));
#pragma unroll
                for (int r = 2; r < 16; r += 2) rm = fmaxf(rm, fmaxf(fmaxf(p0[r], p1[r]), fmaxf(p0[r + 1], p1[r + 1])));
                rm = xhalf_max(rm);
                mn = fmaxf(m, rm + cq2); sub = cq2 - mn;
#pragma unroll
                for (int r = 0; r < 16; r += 2) { const f2 a = (f2){p0[r], p0[r + 1]} + sub, b = (f2){p1[r], p1[r + 1]} + sub;
                    p0[r] = __builtin_amdgcn_exp2f(a.x); p0[r + 1] = __builtin_amdgcn_exp2f(a.y); p1[r] = __builtin_amdgcn_exp2f(b.x); p1[r + 1] = __builtin_amdgcn_exp2f(b.y); }
            } else {
                float rm = fmaxf(fmaxf(p0[0], p1[0]), fmaxf(p0[1], p1[1]));
#pragma unroll
                for (int r = 2; r < 16; r += 2) rm = fmaxf(rm, fmaxf(fmaxf(p0[r], p1[r]), fmaxf(p0[r + 1], p1[r + 1])));
                rm = xhalf_max(rm);
                float bfar = lut2[128];
                if (moba_other && ((selbits >> (t >> 2)) & 1u) == 0u) bfar = NINF;
                mn = fmaxf(m, rm * SC2 + bfar); sub = bfar - mn;
#pragma unroll
                for (int r = 0; r < 16; r += 2) { const f2 a = (f2){p0[r], p0[r + 1]} * SC2 + sub, b = (f2){p1[r], p1[r + 1]} * SC2 + sub;
                    p0[r] = __builtin_amdgcn_exp2f(a.x); p0[r + 1] = __builtin_amdgcn_exp2f(a.y); p1[r] = __builtin_amdgcn_exp2f(b.x); p1[r + 1] = __builtin_amdgcn_exp2f(b.y); }
                if (MODE == 3) {
                    const int w0 = (int)(unsigned)(mb >> (4 * hi)), w1 = (int)(unsigned)(mb >> (32 + 4 * hi));
#pragma unroll
                    for (int r = 0; r < 16; ++r) { const int bit = (r & 3) + 8 * (r >> 2);
                        p0[r] = __uint_as_float(__float_as_uint(p0[r]) & (unsigned)__builtin_amdgcn_sbfe(w0, bit, 1)); p1[r] = __uint_as_float(__float_as_uint(p1[r]) & (unsigned)__builtin_amdgcn_sbfe(w1, bit, 1)); } }
            }
            const float alpha = __builtin_amdgcn_exp2f(m - mn); m = mn;
            f2 acc2 = (f2){0.f, 0.f};
#pragma unroll
            for (int r = 0; r < 16; r += 2) { acc2 += (f2){p0[r], p0[r + 1]}; acc2 += (f2){p1[r], p1[r + 1]}; }
            lsum = lsum * alpha + (acc2.x + acc2.y);
            if (__ballot(alpha != 1.0f) != 0ull) {
#pragma unroll
                for (int r = 0; r < 16; ++r) { o0[r] *= alpha; o1[r] *= alpha; } }
        } else {
            if (MODE == 2) {
                const LAS float* Ct = (const LAS float*)(L + L_C + buf * 256);
#pragma unroll
                for (int g = 0; g < 4; ++g) { const f32x4 ca = *(const LAS f32x4*)(Ct + 8 * g + 4 * hi), cb = *(const LAS f32x4*)(Ct + 32 + 8 * g + 4 * hi);
#pragma unroll
                    for (int i = 0; i < 4; ++i) { p0[4 * g + i] = p0[4 * g + i] * SC2 + (cq2 - ca[i]); p1[4 * g + i] = p1[4 * g + i] * SC2 + (cq2 - cb[i]); } }
            } else {
                if (q0w - (kbase + 63) >= 128) { const float bfar = lut2[128];
#pragma unroll
                    for (int r = 0; r < 16; ++r) { p0[r] = p0[r] * SC2 + bfar; p1[r] = p1[r] * SC2 + bfar; }
                } else {
#pragma unroll
                    for (int r = 0; r < 16; ++r) { int d0_ = tq - (kbase + crow(r, hi)), d1_ = d0_ - 32;
                        d0_ = d0_ < 0 ? 0 : (d0_ > 128 ? 128 : d0_); d1_ = d1_ < 0 ? 0 : (d1_ > 128 ? 128 : d1_);
                        p0[r] = p0[r] * SC2 + lut2[d0_]; p1[r] = p1[r] * SC2 + lut2[d1_]; }
                }
            }
            if (diag) {
#pragma unroll
                for (int r = 0; r < 16; ++r) { const int key = kbase + crow(r, hi); if (key > tq) p0[r] = NINF; if (key + 32 > tq) p1[r] = NINF; }
            }
            if (moba_other) { if (((selbits >> (t >> 2)) & 1u) == 0u) {
#pragma unroll
                    for (int r = 0; r < 16; ++r) { p0[r] = NINF; p1[r] = NINF; } } }
            if (MODE == 3) { const unsigned w0 = (unsigned)(mb >> (4 * hi)), w1 = (unsigned)(mb >> (32 + 4 * hi));
#pragma unroll
                for (int r = 0; r < 16; ++r) { const int bit = (r & 3) + 8 * (r >> 2); if (((w0 >> bit) & 1u) == 0u) p0[r] = NINF; if (((w1 >> bit) & 1u) == 0u) p1[r] = NINF; } }
            float rm = fmaxf(p0[0], p1[0]);
#pragma unroll
            for (int r = 1; r < 16; ++r) rm = fmaxf(rm, fmaxf(p0[r], p1[r]));
            rm = xhalf_max(rm);
            const float mn = fmaxf(m, rm), alpha = __builtin_amdgcn_exp2f(m - mn); m = mn;
            float ps = 0.f;
#pragma unroll
            for (int r = 0; r < 16; ++r) { p0[r] = __builtin_amdgcn_exp2f(p0[r] - mn); p1[r] = __builtin_amdgcn_exp2f(p1[r] - mn); ps += p0[r] + p1[r]; }
            lsum = lsum * alpha + ps;
            if (__ballot(alpha != 1.0f) != 0ull) {
#pragma unroll
                for (int r = 0; r < 16; ++r) { o0[r] *= alpha; o1[r] *= alpha; } }
        }
        const LAS unsigned char* vb = Vt + vboff;
#pragma unroll
        for (int pp = 0; pp < 2; ++pp)
#pragma unroll
            for (int s = 0; s < 2; ++s) {
                const bf16x8 bfrag = pack8(pp == 0 ? p0 : p1, s);
#pragma unroll
                for (int d0 = 0; d0 < 2; ++d0) {
                    const s16x4 lo = vtr(vb + (32 * pp + 16 * s) * KS + 64 * d0), hh = vtr(vb + (32 * pp + 16 * s + 8) * KS + 64 * d0);
                    const bf16x8 afrag = (bf16x8){lo[0], lo[1], lo[2], lo[3], hh[0], hh[1], hh[2], hh[3]};
                    if (d0 == 0) o0 = __builtin_amdgcn_mfma_f32_32x32x16_bf16(afrag, bfrag, o0, 0, 0, 0); else o1 = __builtin_amdgcn_mfma_f32_32x32x16_bf16(afrag, bfrag, o1, 0, 0, 0);
                }
            }
    }
    float inv = 1.0f;
    if (MODE != 0) inv = 1.0f / xhalf_sum(lsum);
    typedef unsigned u32x2 __attribute__((ext_vector_type(2)));
    GAS unsigned short* op = (GAS unsigned short*)(Obase + rowq * 1024 + qcol + 4 * hi);
#pragma unroll
    for (int g = 0; g < 4; ++g) { u32x2 w0, w1;
        w0.x = cvtpk(o0[4 * g] * inv, o0[4 * g + 1] * inv); w0.y = cvtpk(o0[4 * g + 2] * inv, o0[4 * g + 3] * inv);
        w1.x = cvtpk(o1[4 * g] * inv, o1[4 * g + 1] * inv); w1.y = cvtpk(o1[4 * g + 2] * inv, o1[4 * g + 3] * inv);
        *(GAS u32x2*)(op + 8 * g) = w0; *(GAS u32x2*)(op + 32 + 8 * g) = w1; }
    __syncthreads();
}
}
__device__ __forceinline__ void p_attn_mfma(Frame& F, bf16* Obase) {
    const int wave = F.wave;
#pragma unroll 1
    for (int idx = F.vcu; idx < 256; idx += F.G) {
        const int bh = (idx & 7) * 8 + (idx >> 5), s = (idx >> 3) & 3, b = bh >> 2, h = bh & 3; const size_t rb = (size_t)b * SEQ * 1024;
#pragma unroll 1
        for (int k = 0; k < 2; ++k) { const int qb = k ? 7 - s : s;
            att::unit<0>(F, b, h, 256 * qb + 32 * wave, 4 * qb + 4, F_PK + rb + h * 64, F_PV + rb + h * 64, h * 64, Obase); }
#pragma unroll 1
        for (int k = 0; k < 2; ++k) { const int qb = k ? 7 - s : s;
            att::unit<1>(F, b, h, 256 * qb + 32 * wave, 4 * qb + 4, F_PK + rb + 256 + h * 64, F_PV + rb + 256 + h * 64, 256 + h * 64, Obase); }
#pragma unroll 1
        for (int k = 0; k < 2; ++k) { const int qb = k ? 7 - s : s;
            att::unit<2>(F, b, h, 256 * qb + 32 * wave, 4 * qb + 4, F_PK + rb + 512 + h * 64, F_PV + rb + 512 + h * 64, 512 + h * 64, Obase); }
    }
#pragma unroll 1
    for (int idx = F.vcu; idx < 256; idx += F.G) {
        const int b = (idx & 7) * 2 + (idx >> 7), s = (idx >> 3) & 15; const size_t rb = (size_t)b * SEQ * 1024;
#pragma unroll 1
        for (int k = 0; k < 2; ++k) { const int j = k ? 31 - s : s;
            att::unit<3>(F, b, wave & 3, 64 * j + 32 * (wave >> 2), j + 1, F_PK + rb + 768, F_PK + rb + 832, 768 + (wave & 3) * 64, Obase); }
    }
}

__device__ __forceinline__ void idx_item(Frame& F, int b, int pr, const LAS unsigned char* KL) {
    typedef short bf16x8 __attribute__((ext_vector_type(8)));
    const int lane = F.lane, c16 = lane & 15, fq = lane >> 4, half = lane >> 5;
    const int t0 = 2 * pr, tqh = t0 + half;
    GAS unsigned long long* mrow0 = (GAS unsigned long long*)F_MASK + ((size_t)b * SEQ + t0) * 32;
    if (t0 + 1 < 256) {
        unsigned long long m0 = 0ull, m1 = 0ull; const int lo = 64 * lane;
        if (t0 >= lo + 63) m0 = ~0ull; else if (t0 >= lo) m0 = (2ull << (t0 - lo)) - 1ull;
        if (t0 + 1 >= lo + 63) m1 = ~0ull; else if (t0 + 1 >= lo) m1 = (2ull << (t0 + 1 - lo)) - 1ull;
        if (lane < 32) { mrow0[lane] = m0; mrow0[32 + lane] = m1; }
        return;
    }
    const bf16x8 af = *(const GAS bf16x8*)(F_PV + ((size_t)b * SEQ + t0 + (c16 >> 3)) * 1024 + 768 + (c16 & 7) * 32 + 8 * fq);
    f32x4 wv;
    {   typedef unsigned u32x2 __attribute__((ext_vector_type(2)));
        const u32x2 raw = *(const GAS u32x2*)(F_PK + ((size_t)b * SEQ + t0 + (fq >> 1)) * 1024 + 928 + 4 * (fq & 1));
        wv = (f32x4){bflo(raw.x), bfhi(raw.x), bflo(raw.y), bfhi(raw.y)}; }
    const int nk = ((t0 + 1) >> 4) + 1;
    const int klim = tqh - c16;
    unsigned uk[64];
    const LAS bf16x8* kp = (const LAS bf16x8*)(KL + c16 * 64 + fq * 16);
#pragma unroll
    for (int grp = 0; grp < 16; ++grp) {
        if (8 * grp < nk) {
            bf16x8 bfr[8];
#pragma unroll
            for (int i = 0; i < 8; ++i) bfr[i] = kp[(8 * grp + i) * 64];
#pragma unroll
            for (int i = 0; i < 8; ++i) { const int kblk = 8 * grp + i;
                f32x4 d = (f32x4){0.f, 0.f, 0.f, 0.f};
                d = __builtin_amdgcn_mfma_f32_16x16x32_bf16(af, bfr[i], d, 0, 0, 0);
                const float r0 = __int_as_float(max(__float_as_int(d.x), 0)), r1 = __int_as_float(max(__float_as_int(d.y), 0)), r2 = __int_as_float(max(__float_as_int(d.z), 0)), r3 = __int_as_float(max(__float_as_int(d.w), 0));
                const float part = (wv.x * r0 + wv.y * r1) + (wv.z * r2 + wv.w * r3);
                auto rr = __builtin_amdgcn_permlane16_swap(__float_as_uint(part), __float_as_uint(part), false, false);
                const float full = __uint_as_float(rr[0]) + __uint_as_float(rr[1]);
                const int bits = (int)__float_as_uint(full); unsigned uu = (unsigned)bits ^ ((unsigned)(bits >> 31) | 0x80000000u);
                if (16 * kblk + 15 > t0) { if (16 * kblk > klim) uu = 0u; }
                if ((i & 1) == 0) { if ((fq & 1) == 0) uk[kblk >> 1] = uu; } else { if ((fq & 1) == 1) uk[kblk >> 1] = uu; } }
        } else {
#pragma unroll
            for (int i = 0; i < 4; ++i) uk[4 * grp + i] = 0u;
        }
    }
#define IDX_TR_STEP(A, k, j, m) { const unsigned t_ = ((A[k] >> (j)) ^ A[(k) + (j)]) & (m); A[(k) + (j)] ^= t_; A[k] ^= t_ << (j); }
#pragma unroll
    for (int half_ = 0; half_ < 2; ++half_) {
#pragma unroll
        for (int k = 0; k < 16; ++k) IDX_TR_STEP(uk, 32 * half_ + k, 16, 0x0000FFFFu)
#pragma unroll
        for (int k = 0; k < 32; ++k) if ((k & 8) == 0) IDX_TR_STEP(uk, 32 * half_ + k, 8, 0x00FF00FFu)
#pragma unroll
        for (int k = 0; k < 32; ++k) if ((k & 4) == 0) IDX_TR_STEP(uk, 32 * half_ + k, 4, 0x0F0F0F0Fu)
#pragma unroll
        for (int k = 0; k < 32; ++k) if ((k & 2) == 0) IDX_TR_STEP(uk, 32 * half_ + k, 2, 0x33333333u)
#pragma unroll
        for (int k = 0; k < 32; ++k) if ((k & 1) == 0) IDX_TR_STEP(uk, 32 * half_ + k, 1, 0x55555555u)
    }
#undef IDX_TR_STEP
    unsigned cl = ~0u, ch = ~0u, sl = 0u, sh = 0u;
    int need = 256, ncand = 2048;
#pragma unroll
    for (int b = 31; b >= 0; --b) {
        if (__ballot(ncand != need) == 0ull) break;
        const unsigned ol = cl & uk[b], oh = ch & uk[32 + b];
        int n = __popc(ol) + __popc(oh);
        n += __builtin_amdgcn_update_dpp(0, n, 0x111, 0xf, 0xf, true); n += __builtin_amdgcn_update_dpp(0, n, 0x112, 0xf, 0xf, true);
        n += __builtin_amdgcn_update_dpp(0, n, 0x114, 0xf, 0xf, true); n += __builtin_amdgcn_update_dpp(0, n, 0x118, 0xf, 0xf, true);
        const int n0 = __builtin_amdgcn_readlane(n, 15) + __builtin_amdgcn_readlane(n, 31), n1 = __builtin_amdgcn_readlane(n, 47) + __builtin_amdgcn_readlane(n, 63);
        const int c1 = half ? n1 : n0;
        {
            const bool act = ncand != need, ge = c1 >= need, take = act && ge, drop = act && !ge;
            const unsigned dl = drop ? ol : 0u, dh = drop ? oh : 0u; const int dc = drop ? c1 : 0;
            sl |= dl; sh |= dh;
            cl = take ? ol : (cl & ~dl); ch = take ? oh : (ch & ~dh);
            need -= dc; ncand = take ? c1 : ncand - dc; }
    }
#define IDX_BFLY(X, S, M) { const unsigned y_ = (unsigned)__builtin_amdgcn_ds_bpermute((lz ^ (S)) << 2, (int)(X)); X = ((lz & (S)) == 0) ? ((X & (M)) | ((y_ & (M)) << (S))) : (((y_ & ~(M)) >> (S)) | (X & ~(M))); }
    {   int lz = lane; asm volatile("" : "+v"(lz));
        IDX_BFLY(sl, 1, 0x55555555u) IDX_BFLY(sh, 1, 0x55555555u) IDX_BFLY(cl, 1, 0x55555555u) IDX_BFLY(ch, 1, 0x55555555u)
        IDX_BFLY(sl, 2, 0x33333333u) IDX_BFLY(sh, 2, 0x33333333u) IDX_BFLY(cl, 2, 0x33333333u) IDX_BFLY(ch, 2, 0x33333333u)
        IDX_BFLY(sl, 4, 0x0F0F0F0Fu) IDX_BFLY(sh, 4, 0x0F0F0F0Fu) IDX_BFLY(cl, 4, 0x0F0F0F0Fu) IDX_BFLY(ch, 4, 0x0F0F0F0Fu)
        IDX_BFLY(sl, 8, 0x00FF00FFu) IDX_BFLY(sh, 8, 0x00FF00FFu) IDX_BFLY(cl, 8, 0x00FF00FFu) IDX_BFLY(ch, 8, 0x00FF00FFu)
        IDX_BFLY(sl, 16, 0x0000FFFFu) IDX_BFLY(sh, 16, 0x0000FFFFu) IDX_BFLY(cl, 16, 0x0000FFFFu) IDX_BFLY(ch, 16, 0x0000FFFFu)
        unsigned outl = sl | cl, outh = sh | ch;
        if (__ballot(ncand != need) != 0ull) {
            const int r = lz & 31, pcl = __popc(cl), pch = __popc(ch); int inc = pcl | (pch << 16);
#pragma unroll
            for (int o = 1; o < 32; o <<= 1) { const int n_ = __builtin_amdgcn_ds_bpermute(((lz - o) & 63) << 2, inc); if (r >= o) inc += n_; }
            const int tot = __builtin_amdgcn_ds_bpermute((lz | 31) << 2, inc);
            const int before_l = (inc & 0xffff) - pcl, before_h = (tot & 0xffff) + (inc >> 16) - pch;
            int tl = need - before_l; tl = tl < 0 ? 0 : (tl > pcl ? pcl : tl); int th = need - before_h; th = th < 0 ? 0 : (th > pch ? pch : th);
            unsigned el = cl, kl = 0u; for (int k = 0; k < tl; ++k) { const unsigned low = el & (0u - el); kl |= low; el ^= low; }
            unsigned eh = ch, kh = 0u; for (int k = 0; k < th; ++k) { const unsigned low = eh & (0u - eh); kh |= low; eh ^= low; }
            outl = sl | kl; outh = sh | kh; }
        GAS unsigned* mw = (GAS unsigned*)(mrow0 + 32 * half) + (lz & 31);
        mw[0] = outl; mw[32] = outh; }
#undef IDX_BFLY
}
__device__ __forceinline__ void p_prep(Frame& F, int l) {
    const int gw = F.vcu * NWAVES + F.wave, NGW = F.G * NWAVES, lane = F.lane;
    for (int it = gw; it < NB * 4; it += NGW) {
        const int b = it >> 2, h = it & 3; const float bfv = inp(5)[l * 4 + h];
        float v[32]; float run = 0.f;
#pragma unroll
        for (int i = 0; i < 32; ++i) { const float x = bf2f(*(const GAS unsigned short*)(F_PK + ((size_t)b * SEQ + lane * 32 + i) * 1024 + 936 + h)) + bfv;
            run += fminf(x, 0.f) - 0.6931471805599453f * __builtin_amdgcn_logf(1.0f + __builtin_amdgcn_exp2f(-1.4426950408889634f * fabsf(x))); v[i] = run; }
        float incl = run;
#pragma unroll
        for (int o = 1; o < 64; o <<= 1) { const float n = __builtin_bit_cast(float, __builtin_amdgcn_ds_bpermute(((lane - o) & 63) << 2, __builtin_bit_cast(int, incl))); if (lane >= o) incl += n; }
        const float off = incl - run;
        GAS float* cp = (GAS float*)F_CUM + (size_t)it * SEQ + lane * 32;
#pragma unroll
        for (int i = 0; i < 32; ++i) cp[i] = v[i] + off;
    }
    for (int it = gw; it < NB * 4 * 8; it += NGW) {
        const int n = it & 7, h = (it >> 3) & 3, b = it >> 5;
        const GAS v4u* kp = (const GAS v4u*)(F_PK + ((size_t)b * SEQ + n * 256 + (lane >> 3)) * 1024 + 256 + h * 64 + (lane & 7) * 8);
        float s[8];
#pragma unroll
        for (int e = 0; e < 8; ++e) s[e] = 0.f;
#pragma unroll 8
        for (int j = 0; j < 32; ++j) { const v4u r = kp[(size_t)j * (8 * 1024 / 8)];
            s[0] += bflo(r.x); s[1] += bfhi(r.x); s[2] += bflo(r.y); s[3] += bfhi(r.y); s[4] += bflo(r.z); s[5] += bfhi(r.z); s[6] += bflo(r.w); s[7] += bfhi(r.w); }
#pragma unroll
        for (int e = 0; e < 8; ++e) { s[e] += shx(s[e], lane, 8); s[e] += shx(s[e], lane, 16); s[e] += shx(s[e], lane, 32); }
        if (lane < 8) { GAS f32x4* o = (GAS f32x4*)((GAS float*)F_KMEAN + (size_t)it * 64 + lane * 8);
            o[0] = (f32x4){s[0], s[1], s[2], s[3]} * (1.f / 256.f); o[1] = (f32x4){s[4], s[5], s[6], s[7]} * (1.f / 256.f); }
    }
#pragma unroll 1
    for (int it = gw, k = 0; it < NB * (SEQ / 2); it += NGW, ++k) { const int b = it >> 10; int pr = it & 1023; if (k & 1) pr = 1023 - pr;
        const int prw0 = (it - F.wave) & 1023, prmax = (k & 1) ? 1023 - prw0 : prw0 + 7; int nkeys = (2 * prmax + 2 + 15) & ~15; if (nkeys > SEQ) nkeys = SEQ;
        LAS unsigned char* KL = F.lds + RING_OFF;
        __syncthreads();
        if (2 * prmax + 1 >= 256) {
            for (int p0 = F.tid; p0 < nkeys * 4; p0 += 4 * 512) { v4u v[4];
#pragma unroll
                for (int u = 0; u < 4; ++u) { const int p_ = p0 + u * 512; if (p_ < nkeys * 4) v[u] = *(const GAS v4u*)(F_PK + ((size_t)b * SEQ + (p_ >> 2)) * 1024 + 896 + (p_ & 3) * 8); }
#pragma unroll
                for (int u = 0; u < 4; ++u) { const int p_ = p0 + u * 512; if (p_ < nkeys * 4) *(LAS v4u*)(KL + (p_ >> 2) * 64 + (p_ & 3) * 16) = v[u]; } } }
        __syncthreads();
        idx_item(F, b, pr, KL); }
}

__device__ __forceinline__ void attn_item(Frame& F, int mode, int b, int h, int qblk) {
    const int lane = F.lane, ql = lane & 31, hf = lane >> 5;
    LAS unsigned char* Ks = F.lds + RING_OFF + F.wave * 16384; LAS unsigned char* Vs = Ks + 8192;
    LAS float* cs = (LAS float*)(F.lds + AUX_OFF + F.wave * 256);
    const LAS float* lut = (const LAS float*)(F.lds + LUT_OFF) + ((mode == 3 ? 4 : 0) + h) * LUT_STRIDE;
    const int t0 = qblk * 32, t = t0 + ql; const size_t rowq = (size_t)b * SEQ + t;
    int qcol; const bf16* Kb; const bf16* Vb;
    if (mode == 0) { qcol = h * 64; Kb = F_PK + h * 64; Vb = F_PV + h * 64; }
    else if (mode == 1) { qcol = 256 + h * 64; Kb = F_PK + 256 + h * 64; Vb = F_PV + 256 + h * 64; }
    else if (mode == 2) { qcol = 512 + h * 64; Kb = F_PK + 512 + h * 64; Vb = F_PV + 512 + h * 64; }
    else { qcol = 768 + h * 64; Kb = F_PK + 768; Vb = F_PK + 832; }
    float qv[32];
    {   const GAS v4u* qp = (const GAS v4u*)(F_PQ + rowq * 1024 + qcol + 32 * hf);
#pragma unroll
        for (int i = 0; i < 4; ++i) { const v4u r = qp[i]; qv[8 * i + 0] = 0.125f * bflo(r.x); qv[8 * i + 1] = 0.125f * bfhi(r.x); qv[8 * i + 2] = 0.125f * bflo(r.y); qv[8 * i + 3] = 0.125f * bfhi(r.y);
            qv[8 * i + 4] = 0.125f * bflo(r.z); qv[8 * i + 5] = 0.125f * bfhi(r.z); qv[8 * i + 6] = 0.125f * bflo(r.w); qv[8 * i + 7] = 0.125f * bfhi(r.w); }
    }
    float o[32];
#pragma unroll
    for (int d = 0; d < 32; ++d) o[d] = 0.f;
    float mx = -1e30f, lsum = 0.f, E = 0.f;
    const int own = qblk >> 3; unsigned selbits = 0u;
    if (mode == 1) {
        float gt[7];
#pragma unroll
        for (int n = 0; n < 7; ++n) { gt[n] = 0.f;
            if (n < own) { const GAS f32x4* kmp = vptr((const GAS f32x4*)((const GAS float*)F_KMEAN + ((size_t)((b * 4 + h) * 8 + n)) * 64)) + 8 * hf; float g = 0.f;
#pragma unroll
                for (int i = 0; i < 8; ++i) { const f32x4 km = kmp[i]; g += qv[4 * i] * km.x + qv[4 * i + 1] * km.y + qv[4 * i + 2] * km.z + qv[4 * i + 3] * km.w; }
                gt[n] = g + __shfl_xor(g, 32); } }
#pragma unroll
        for (int n = 0; n < 7; ++n) if (n < own) { int rank = 0;
#pragma unroll
            for (int m2 = 0; m2 < 7; ++m2) if (m2 != n && m2 < own) rank += ((gt[m2] > gt[n]) || (gt[m2] == gt[n] && m2 < n)) ? 1 : 0;
            if (rank < 3) selbits |= 1u << n; }
    }
    float cq = 0.f;
    if (mode == 2) cq = ((const GAS float*)F_CUM)[(size_t)(b * 4 + h) * SEQ + t];
    const GAS unsigned long long* mrow = (const GAS unsigned long long*)F_MASK + rowq * 32;
    const int nch = (qblk >> 1) + 1;
#pragma unroll 1
    for (int ci = 0; ci < nch; ++ci) {
        const int c = (mode == 0) ? (nch - 1 - ci) : ci; const int nblk = c >> 2;
        if (mode == 1 && nblk != own && __ballot((selbits >> nblk) & 1u) == 0ull) continue;
        asm volatile("s_waitcnt lgkmcnt(0)" ::: "memory");
        const size_t krow0 = (size_t)b * SEQ + 64 * c;
#pragma unroll
        for (int i = 0; i < 8; ++i) { const int r = i * 8 + (lane >> 3), pc = lane & 7;
            const v4u kk = *(const GAS v4u*)(Kb + (krow0 + r) * 1024 + pc * 8); const v4u vv = *(const GAS v4u*)(Vb + (krow0 + r) * 1024 + pc * 8);
            *(LAS v4u*)(Ks + r * 128 + pc * 16) = kk; *(LAS v4u*)(Vs + r * 128 + pc * 16) = vv; }
        if (mode == 2) cs[lane] = ((const GAS float*)F_CUM)[(size_t)(b * 4 + h) * SEQ + 64 * c + lane];
        unsigned long long mb = ~0ull; if (mode == 3) mb = mrow[c];
        asm volatile("s_waitcnt vmcnt(0) lgkmcnt(0)" ::: "memory");
        const bool selblk = (mode != 1) || (nblk == own) || (((selbits >> nblk) & 1u) != 0u);
#pragma unroll 1
        for (int jj = 0; jj < 64; ++jj) {
            const int j = (mode == 0) ? 63 - jj : jj; const int s = 64 * c + j;
            if (s > t0 + 31) continue;
            float dot = 0.f;
#pragma unroll
            for (int i = 0; i < 4; ++i) { const v4u kk = *(const LAS v4u*)(Ks + j * 128 + hf * 64 + i * 16);
                dot += qv[8 * i + 0] * bflo(kk.x) + qv[8 * i + 1] * bfhi(kk.x) + qv[8 * i + 2] * bflo(kk.y) + qv[8 * i + 3] * bfhi(kk.y)
                     + qv[8 * i + 4] * bflo(kk.z) + qv[8 * i + 5] * bfhi(kk.z) + qv[8 * i + 6] * bflo(kk.w) + qv[8 * i + 7] * bfhi(kk.w); }
            dot += __shfl_xor(dot, 32);
            float p;
            if (mode == 0) {
                const bool valid = s < t;
                const float sp = fmaxf(dot, 0.f) + __logf(1.0f + __expf(-fabsf(dot)));
                p = valid ? __expf(dot - sp + E) : 0.f; E += valid ? -sp : 0.f;
            } else {
                const bool valid = (s <= t) && selblk && (((mb >> j) & 1ull) != 0ull);
                float logit = dot;
                if (mode == 2) logit += cq - cs[j];
                if (mode == 1 || mode == 3) { int dist = t - s; dist = dist < 0 ? 0 : (dist > 128 ? 128 : dist); logit += lut[dist]; }
                if (valid && logit > mx + 8.0f) { const float f = __expf(mx - logit); lsum *= f;
#pragma unroll
                    for (int d = 0; d < 32; ++d) o[d] *= f;
                    mx = logit; }
                p = valid ? __expf(logit - mx) : 0.f; lsum += p;
            }
#pragma unroll
            for (int i = 0; i < 4; ++i) { const v4u vv = *(const LAS v4u*)(Vs + j * 128 + hf * 64 + i * 16);
                o[8 * i + 0] += p * bflo(vv.x); o[8 * i + 1] += p * bfhi(vv.x); o[8 * i + 2] += p * bflo(vv.y); o[8 * i + 3] += p * bfhi(vv.y);
                o[8 * i + 4] += p * bflo(vv.z); o[8 * i + 5] += p * bfhi(vv.z); o[8 * i + 6] += p * bflo(vv.w); o[8 * i + 7] += p * bfhi(vv.w); }
        }
    }
    const float inv = (mode == 0) ? 1.0f : 1.0f / lsum;
    GAS v4u* op = (GAS v4u*)(F_PQ + rowq * 1024 + qcol + 32 * hf);
#pragma unroll
    for (int i = 0; i < 4; ++i) { v4u w; w.x = pk2(o[8 * i + 0] * inv, o[8 * i + 1] * inv); w.y = pk2(o[8 * i + 2] * inv, o[8 * i + 3] * inv); w.z = pk2(o[8 * i + 4] * inv, o[8 * i + 5] * inv); w.w = pk2(o[8 * i + 6] * inv, o[8 * i + 7] * inv); op[i] = w; }
}
__device__ __forceinline__ void p_attn(Frame& F) {
    const int gw = F.vcu * NWAVES + F.wave, NGW = F.G * NWAVES;
#pragma unroll 1
    for (int mode = 0; mode < 4; ++mode)
#pragma unroll 1
        for (int r = gw; r < NB * 4 * 64; r += NGW) { const int bh = r >> 6; int qb = r & 63; if (mode & 1) qb = 63 - qb; attn_item(F, mode, bh >> 2, bh & 3, qb); }
}

__device__ __forceinline__ void p_fixup(Frame& F, int l) {
    const int gw = F.vcu * NWAVES + F.wave, NGW = F.G * NWAVES, lane = F.lane;
    const float* cw = inp(11) + (size_t)l * 3 * NUP; const float* cb = inp(12) + (size_t)l * NUP;
    typedef unsigned u32x2 __attribute__((ext_vector_type(2)));
    for (int it = gw; it < (MTOK / 64) * 11; it += NGW) {
        const int ck = it / 11, cbk = it % 11, f = cbk * 256 + lane * 4, c0 = ck * 64;
        const f32x4 wg0_ = *(const GAS f32x4*)(cw + f), wg1_ = *(const GAS f32x4*)(cw + NUP + f), wg2_ = *(const GAS f32x4*)(cw + 2 * NUP + f), bg = *(const GAS f32x4*)(cb + f);
        const f32x4 swg = *(const GAS f32x4*)(F_CMAXU + (size_t)l * NUP + f) * (1.0f / 127.0f), swu = *(const GAS f32x4*)(F_CMAXU + (size_t)l * NUP + DFF + f) * (1.0f / 127.0f);
        const f32x4 wu0 = *(const GAS f32x4*)(cw + DFF + f) * swu, wu1 = *(const GAS f32x4*)(cw + NUP + DFF + f) * swu, wu2 = *(const GAS f32x4*)(cw + 2 * NUP + DFF + f) * swu, bu = *(const GAS f32x4*)(cb + DFF + f);
        const f32x4 wg0 = wg0_ * swg, wg1 = wg1_ * swg, wg2 = wg2_ * swg;
        auto ld4 = [](const GAS unsigned short* p) -> f32x4 { const u32x2 raw = *(const GAS u32x2*)p; return (f32x4){bflo(raw.x), bfhi(raw.x), bflo(raw.y), bfhi(raw.y)}; };
        const GAS unsigned short* hb = (const GAS unsigned short*)F_HALO + (size_t)ck * 4 * NUP + f;
        f32x4 gm2 = (f32x4){0.f, 0.f, 0.f, 0.f}, gm1 = gm2, um2 = gm2, um1 = gm2;
        if ((c0 & (SEQ - 1)) != 0) { gm2 = ld4(hb - 2 * (size_t)NUP); gm1 = ld4(hb - (size_t)NUP); um2 = ld4(hb - 2 * (size_t)NUP + DFF); um1 = ld4(hb - (size_t)NUP + DFF); }
        const f32x4 g0 = ld4(hb), g1 = ld4(hb + NUP), u0 = ld4(hb + DFF), u1 = ld4(hb + NUP + DFF);
        const f32x4 cg0 = bg + wg0 * gm2 + wg1 * gm1 + wg2 * g0, cu0 = bu + wu0 * um2 + wu1 * um1 + wu2 * u0;
        const f32x4 cg1 = bg + wg0 * gm1 + wg1 * g0 + wg2 * g1, cu1 = bu + wu0 * um1 + wu1 * u0 + wu2 * u1;
        GAS unsigned short* ob = (GAS unsigned short*)F_ACT + (((size_t)(c0 >> 8) * (DFF / 64) + (f >> 6)) * 256 + (c0 & 255)) * 64 + (f & 63);
        {   const pg8::f32x2 a = pg8::gelu_pk((pg8::f32x2){cg0[0], cg0[1]}), c2 = pg8::gelu_pk((pg8::f32x2){cg0[2], cg0[3]});
            u32x2 w; w.x = pk2(a.x * cu0[0], a.y * cu0[1]); w.y = pk2(c2.x * cu0[2], c2.y * cu0[3]); *(GAS u32x2*)ob = w; }
        {   const pg8::f32x2 a = pg8::gelu_pk((pg8::f32x2){cg1[0], cg1[1]}), c2 = pg8::gelu_pk((pg8::f32x2){cg1[2], cg1[3]});
            u32x2 w; w.x = pk2(a.x * cu1[0], a.y * cu1[1]); w.y = pk2(c2.x * cu1[2], c2.y * cu1[3]); *(GAS u32x2*)(ob + 64) = w; }
    }
}

#ifndef STAGGER_PCT
#define STAGGER_PCT 0
#endif
__device__ __forceinline__ void stagger(const Frame& F, int ticks) { if (STAGGER_PCT > 0 && (F.vcu & 1)) { const unsigned long long t0 = __builtin_amdgcn_s_memrealtime(); while (__builtin_amdgcn_s_memrealtime() - t0 < (unsigned long long)(ticks * STAGGER_PCT / 100)) __builtin_amdgcn_s_sleep(16); } }
__device__ __forceinline__ void run_layer(Frame& F, const int l, const int lo, const int hi, const XcdBarrier& bar, const int vcu0, unsigned char* const ws0, const int wave0) {
#define GRID_BAR() do { if (MK_N_LAUNCHES == 1) xcd_barrier(bar); } while (0)
#define IN(k) (lo <= (k) && (k) < hi)
#define BOTH(k) (IN(k) && IN((k) + 1))
#define FRESH() do { int w_s = wave0; asm volatile("" : "+s"(w_s)); int l_; asm volatile("v_mbcnt_lo_u32_b32 %0, -1, 0\n\tv_mbcnt_hi_u32_b32 %0, -1, %0" : "=v"(l_)); F.tid = (w_s << 6) + l_; F.lane = l_; F.wave = w_s;     int v_ = vcu0; asm volatile("" : "+s"(v_)); F.vcu = v_; unsigned char* w_ = ws0; asm volatile("" : "+s"(w_)); F.ws = w_; } while (0)
        const int g0 = l * NP;
        if (hi <= g0 || lo >= g0 + NP) return;
        const size_t wofs = (l & 1) ? WS_WALT : 0;
        if (IN(g0 + 0)) { FRESH(); if (l == 0) { p_wmax(F); GRID_BAR(); p_wconv(F, 0, 0); p_init(F); } else p_quant0(F); if (BOTH(g0 + 0)) GRID_BAR(); }
        if (IN(g0 + 1)) { FRESH();
            pg8::Gemm g{(const bf16*)F_X8, (const bf16*)F_WIN8, MTOK, NPROJ, DM / 2, DM / 2, -1, 0, 0};   pg8::StaticOrder S; S.init(MTOK, NPROJ, F.G, (int)blockIdx.x);
            pg8::EpiProjS8 E{F_PQ, (size_t)(WS_PK - WS_PQ) / 2, F_SSA1, F_SX, F_SWIN}; stagger(F, 2800);
#pragma unroll 1
            for (int rep_ = 0; rep_ < ((PROBE_MASK >> 1) & 1) + 1; ++rep_) { if (rep_) GRID_BAR();
            pg8::gemm_phase<pg8::EpiProjS8, pg8::StaticOrder, true, true, true>(F.lds + RING_OFF, g, S, E, F.tid); }
            if (BOTH(g0 + 1)) GRID_BAR();
        }
        if (IN(g0 + 2)) { FRESH();
#if PROBE_MASK & 4
            if (l + 1 < DEPTH) p_wconv(F, l + 1, ((l + 1) & 1) ? WS_WALT : 0); p_quant(F, l); p_prep(F, l); GRID_BAR();
#endif
            if (l + 1 < DEPTH) p_wconv(F, l + 1, ((l + 1) & 1) ? WS_WALT : 0); p_quant(F, l); p_prep(F, l); if (BOTH(g0 + 2)) GRID_BAR(); }
        if (IN(g0 + 3)) { FRESH();
#if defined(NAIVE_ATTN)
            p_attn(F);
#else
#if PROBE_MASK & 8
            p_attn_mfma(F, (bf16*)(F.ws + 320 * MiB)); GRID_BAR();
#endif
            p_attn_mfma(F, F_PQ);
#endif
 if (BOTH(g0 + 3)) GRID_BAR(); }
        if (IN(g0 + 4)) { FRESH();
            pg8::Gemm g{F_PQ, F_WbT, MTOK, 4096, 256, 1024, 2, 0, 0}; pg8::StaticOrder S; S.init(MTOK, 4096, F.G, (int)blockIdx.x);
            pg8::EpiBvQ8 E{F_BVQ}; stagger(F, 1600);
#if PROBE_MASK & 2048
            { pg8::EpiNull E0{}; pg8::gemm_phase<pg8::EpiNull, pg8::StaticOrder, true, true>(F.lds + RING_OFF, g, S, E0, F.tid); GRID_BAR(); }
#endif
#if PROBE_MASK & 8192
            { pg8::EpiHalf E0{F_BV, 4096}; pg8::gemm_phase<pg8::EpiHalf, pg8::StaticOrder, true, true>(F.lds + RING_OFF, g, S, E0, F.tid); GRID_BAR(); }
#endif
#if PROBE_MASK & 4096
            { pg8::EpiBf16T E0{F_BV, 4096, F.lds + AUX_OFF}; pg8::gemm_phase<pg8::EpiBf16T, pg8::StaticOrder, true, true>(F.lds + RING_OFF, g, S, E0, F.tid); GRID_BAR(); }
#endif
#pragma unroll 1
            for (int rep_ = 0; rep_ < ((PROBE_MASK >> 4) & 1) + 1; ++rep_) { if (rep_) GRID_BAR();
            pg8::gemm_phase<pg8::EpiBvQ8, pg8::StaticOrder, true, true>(F.lds + RING_OFF, g, S, E, F.tid); }
            if (BOTH(g0 + 4)) GRID_BAR();
        }
        if (IN(g0 + 5)) { FRESH();
            pg8::Gemm g{(const bf16*)F_X8, (const bf16*)F_WG8, MTOK, 4096, DM / 2, DM / 2, -1, 0, 0};   pg8::StaticOrder S; S.init(MTOK, 4096, F.G, (int)blockIdx.x);
            pg8::EpiGateMix8 E{F_BVQ, F_MIX, F_SSA1, F_SX, (const unsigned*)(F_CTL + CW_WMAXG + l)}; stagger(F, 3000);
#pragma unroll 1
            for (int rep_ = 0; rep_ < ((PROBE_MASK >> 5) & 1) + 1; ++rep_) { if (rep_) GRID_BAR();
            pg8::gemm_phase<pg8::EpiGateMix8, pg8::StaticOrder, true, true, true>(F.lds + RING_OFF, g, S, E, F.tid); }
            if (BOTH(g0 + 5)) GRID_BAR();
        }
        if (IN(g0 + 6)) { FRESH();
            pg8::Gemm g{F_MIX, F_WoT, MTOK, DM, DM, DM, -1, 0, 0}; pg8::StaticOrder S; S.init(MTOK, DM, F.G, (int)blockIdx.x);
            pg8::EpiResB E{F_XB, DM, F_SSB, (LAS float*)(F.lds + AUX_OFF)}; stagger(F, 2600);
#if (PROBE_MASK & 64)
            { pg8::EpiResB E0{(bf16*)(F.ws + 320 * MiB), DM, (float*)(F.ws + 384 * MiB), (LAS float*)(F.lds + AUX_OFF)}; pg8::gemm_phase<pg8::EpiResB, pg8::StaticOrder, true, true>(F.lds + RING_OFF, g, S, E0, F.tid); GRID_BAR(); }
#endif
            pg8::gemm_phase<pg8::EpiResB, pg8::StaticOrder, true, true>(F.lds + RING_OFF, g, S, E, F.tid);
            if (BOTH(g0 + 6)) GRID_BAR();
        }
        if (IN(g0 + 7)) { FRESH(); p_quant1(F); if (BOTH(g0 + 7)) GRID_BAR(); }
        if (IN(g0 + 8)) { FRESH();
            pg8::Gemm g{(const bf16*)F_X18, (const bf16*)F_WUP8, MTOK, NUP, DM / 2, DM / 2, -1, 0, 0};   pg8::StaticOrder S; S.init(MTOK, NUP, F.G, (int)blockIdx.x);
            pg8::EpiConvGelu8 E{F_ACT, F_HALO, inp(11) + (size_t)l * 3 * NUP, inp(12) + (size_t)l * NUP, F_SSB1, F_SX1, F_CMAXU + (size_t)l * NUP}; stagger(F, 2800);
#pragma unroll 1
            for (int rep_ = 0; rep_ < ((PROBE_MASK >> 8) & 1) + 1; ++rep_) { if (rep_) GRID_BAR();
            pg8::gemm_phase<pg8::EpiConvGelu8, pg8::StaticOrder, true, true, true>(F.lds + RING_OFF, g, S, E, F.tid); }
            if (BOTH(g0 + 8)) GRID_BAR();
        }
        if (IN(g0 + 9)) { FRESH(); p_fixup(F, l); if (BOTH(g0 + 9)) GRID_BAR(); }
        if (IN(g0 + 10)) { FRESH();
            pg8::Gemm g{F_ACT, F_WdT, MTOK, DM, DFF, 64, -1, (size_t)32768, (size_t)(DFF / 64) * 32768};   pg8::StaticOrder S; S.init(MTOK, DM, F.G, (int)blockIdx.x);
            pg8::EpiResB E{F_XB, DM, F_SSA, (LAS float*)(F.lds + AUX_OFF)}; stagger(F, 6000);
#if (PROBE_MASK & 1024)
            { pg8::EpiResBT<(PROBE_MASK & 512) == 0> E0{(bf16*)(F.ws + 320 * MiB), DM, (float*)(F.ws + 384 * MiB), (LAS float*)(F.lds + AUX_OFF)}; pg8::gemm_phase<pg8::EpiResBT<(PROBE_MASK & 512) == 0>, pg8::StaticOrder, true, true>(F.lds + RING_OFF, g, S, E0, F.tid); GRID_BAR(); }
#endif
            pg8::gemm_phase<pg8::EpiResB, pg8::StaticOrder, true, true>(F.lds + RING_OFF, g, S, E, F.tid);
            if (BOTH(g0 + 10)) GRID_BAR();
        }

#undef IN
#undef BOTH
#undef GRID_BAR
#undef FRESH
}

__global__ void __launch_bounds__(NWAVES * 64, 2) fwd(Args args) {
    extern __shared__ __attribute__((aligned(16))) unsigned char lds[];
    Frame F;
    F.lds = (LAS unsigned char*)lds;
    F.MISC = (volatile LAS unsigned*)(F.lds + MISC_OFF);
    F.tid = threadIdx.x; F.lane = F.tid & 63; F.wave = __builtin_amdgcn_readfirstlane(F.tid >> 6);
    F.G = gridDim.x; { const int bx = blockIdx.x; F.vcu = (F.G % 8 == 0) ? (bx % 8) * (F.G / 8) + bx / 8 : bx; }
    F.ws = args.ws; const int vcu0 = F.vcu, wave0 = F.wave; unsigned char* const ws0 = args.ws;
    for (int u = F.tid; u < (LDS_BYTES - LDSCTL_OFF) / 4; u += NWAVES * 64) ((LAS unsigned*)(F.lds + LDSCTL_OFF))[u] = 0u;
    for (int u = F.tid; u < 8 * 129; u += NWAVES * 64) { const int hh = u / 129, n = u % 129; int bk;
        if (n < 16) bk = n; else if (n >= 128) bk = 31; else { bk = 16 + (n >= 19) + (n >= 21) + (n >= 24) + (n >= 27) + (n >= 31) + (n >= 35) + (n >= 40) + (n >= 46) + (n >= 52) + (n >= 59) + (n >= 67) + (n >= 77) + (n >= 87) + (n >= 99) + (n >= 113); }
        const float tv = inp(6)[bk * 8 + hh]; ((LAS float*)(F.lds + LUT_OFF))[hh * LUT_STRIDE + n] = tv; ((LAS float*)(F.lds + LUT2_OFF))[hh * LUT_STRIDE + n] = tv * 1.4426950408889634f; }
    __syncthreads();
    XcdBarrier bar; bar.bar = (unsigned*)(F_CTL + CW_BAR); bar.x = 0; bar.st = nullptr;
    if (MK_N_LAUNCHES == 1) bar = xcd_barrier_post((unsigned*)(F_CTL + CW_BAR), F.MISC + 8);
#define GRID_BAR() do { if (MK_N_LAUNCHES == 1) xcd_barrier(bar); } while (0)
    const int lo = args.g_lo, hi = args.g_hi;
#define IN(k) (lo <= (k) && (k) < hi)
#define FRESH() do { int w_s = wave0; asm volatile("" : "+s"(w_s)); int l_; asm volatile("v_mbcnt_lo_u32_b32 %0, -1, 0\n\tv_mbcnt_hi_u32_b32 %0, -1, %0" : "=v"(l_)); F.tid = (w_s << 6) + l_; F.lane = l_; F.wave = w_s;     int v_ = vcu0; asm volatile("" : "+s"(v_)); F.vcu = v_; unsigned char* w_ = ws0; asm volatile("" : "+s"(w_)); F.ws = w_; } while (0)
#define BOTH(k) (IN(k) && IN((k) + 1))
#pragma unroll 1
    for (int l = 0; l < DEPTH; ++l) run_layer(F, l, lo, hi, bar, vcu0, ws0, wave0);
    if (IN(DEPTH * NP)) { FRESH(); p_final(F, outp(), inp(3)); }
#undef IN
#undef FRESH
#undef BOTH
#undef GRID_BAR
}

extern "C" void kernel_launch(void* const* d_in, const int* in_sizes, int n_in, void* d_out, int out_size, void* d_ws, size_t ws_size, hipStream_t stream) {
    static int grid = 0;
    if (grid == 0) {
        if (n_in != 14 || out_size != MTOK * DM || ws_size < WS_END) { fprintf(stderr, "kernel_launch: unexpected shapes (n_in %d, out %d, ws %zu)\n", n_in, out_size, ws_size); grid = -1; return; }
        int dev = 0, cus = 0, per_cu = 0;
        if (hipGetDevice(&dev) != hipSuccess || hipDeviceGetAttribute(&cus, hipDeviceAttributeMultiprocessorCount, dev) != hipSuccess) { grid = -1; return; }
        if (hipFuncSetAttribute((const void*)fwd, hipFuncAttributeMaxDynamicSharedMemorySize, LDS_BYTES) != hipSuccess) { fprintf(stderr, "kernel_launch: hipFuncSetAttribute failed\n"); grid = -1; return; }
        if (hipOccupancyMaxActiveBlocksPerMultiprocessor(&per_cu, (const void*)fwd, NWAVES * 64, LDS_BYTES) != hipSuccess || per_cu < 1) fprintf(stderr, "kernel_launch: occupancy query reports %d\n", per_cu);
        (void)hipGetLastError();
        if (cus != 256) { fprintf(stderr, "kernel_launch: %d CUs (the phases deal whole rounds to a grid of 256 workgroups)\n", cus); grid = -1; return; }
        grid = cus;
    }
    if (grid < 0) return;
    if (hipMemsetAsync((char*)d_ws + WS_CTL, 0, CTL_ZERO_BYTES, stream) != hipSuccess) return;
    Args a{};
    for (int i = 0; i < 14; ++i) a.in[i] = (const float*)d_in[i];
    a.out = (float*)d_out; a.ws = (unsigned char*)d_ws;
#if MK_N_LAUNCHES == 1
    a.g_lo = 0; a.g_hi = NPH; a.li = 0;
    hipLaunchKernelGGL(fwd, dim3(grid), dim3(NWAVES * 64), LDS_BYTES, stream, a);
#else
    for (int g = 0; g < NPH; ++g) { a.g_lo = g; a.g_hi = g + 1; a.li = g; hipLaunchKernelGGL(fwd, dim3(grid), dim3(NWAVES * 64), LDS_BYTES, stream, a); }
#endif
}
```

```cpp
#include <hip/hip_runtime.h>
#include <cstdio>
#include <cstdint>
#ifndef MK_N_LAUNCHES
#define MK_N_LAUNCHES 1
#endif
namespace pg8 {
#define PG8_LAS __attribute__((address_space(3)))
#define PG8_GAS __attribute__((address_space(1)))
typedef unsigned short bf16_t;
typedef short bf16x8 __attribute__((ext_vector_type(8)));
typedef float f32x4 __attribute__((ext_vector_type(4)));
typedef unsigned u32x4 __attribute__((ext_vector_type(4)));
constexpr int BM = 256, BK = 64, HALF = 128, HTB = HALF * BK * 2  , STAGE_BYTES = 8 * HTB, NXCD = 8, WGM = 8;

__host__ __device__ __forceinline__ int lds_byte(int r, int c) { const int st = (r >> 4) * 2 + (c >> 5), rr = r & 15, cc = c & 31, ob = rr * 64 + cc * 2; return st * 1024 + (ob ^ (((ob >> 9) & 1) << 5)); }
__host__ __device__ __forceinline__ void stage_rc(int b, int& R, int& C) { const int st = b / 1024, sb = b % 1024, swz = sb ^ (((sb >> 9) & 1) << 5); R = (st >> 1) * 16 + swz / 64; C = (st & 1) * 32 + (swz % 64) / 2; }
__host__ __device__ __forceinline__ int perm32(int rho) { const int n = rho >> 4, i = rho & 15; return 8 * (i >> 2) + 4 * n + (i & 3); }

struct Unit { int pm, pn; };
struct Gemm { const bf16_t* A; const bf16_t* Bt; int M, N, K; int lda; int a_sh; size_t kstepA, tstepA; };

struct StaticOrder {
    int nM, nN, nwg, G, c;
    __host__ __device__ void init(int M, int N, int G_, int c_) { nM = M / BM; nN = N / BM; nwg = nM * nN; G = G_; c = c_; }
    __host__ __device__ bool next(int i, Unit& u) const {
        const long L = (long)i * G + c; if (L >= nwg) return false;
        int wgid = (int)L; { const int q = nwg / NXCD, r = nwg % NXCD, xcd = wgid % NXCD, off = wgid / NXCD; wgid = (xcd < r ? xcd * (q + 1) : r * (q + 1) + (xcd - r) * q) + off; }
        const int nig = WGM * nN, gid = wgid / nig, fm = gid * WGM, gsz = (nM - fm) < WGM ? (nM - fm) : WGM;
        u.pm = fm + ((wgid % nig) % gsz); u.pn = (wgid % nig) / gsz; return true;
    }
    __device__ __forceinline__ void a_ready(const Unit&) const {}
    __device__ __forceinline__ void done(const Unit&) const {}
};

__device__ __forceinline__ unsigned cvt_pk_bf16(float lo, float hi) { unsigned r; asm volatile("v_cvt_pk_bf16_f32 %0, %1, %2" : "=v"(r) : "v"(lo), "v"(hi)); return r; }
typedef float f32x2 __attribute__((ext_vector_type(2)));
__device__ __forceinline__ f32x2 gelu_pk(f32x2 v) {
    const f32x2 av = __builtin_elementwise_abs(v), d = av * 0.2316418882f + 1.0f;
    f32x2 t; t.x = __builtin_amdgcn_rcpf(d.x); t.y = __builtin_amdgcn_rcpf(d.y);
    f32x2 q = t * 0.5307027145f + (-0.7265760135f); q = q * t + 0.7107068705f; q = q * t + (-0.142248368f); q = q * t + 0.127414796f; q = q * t;
    const f32x2 s = (v * v) * (-0.72134752044f);
    f32x2 e; e.x = __builtin_amdgcn_exp2f(s.x); e.y = __builtin_amdgcn_exp2f(s.y);
    const f32x2 m = v * (q * e), r = v - m;
    f32x2 o; o.x = v.x < 0.f ? m.x : r.x; o.y = v.y < 0.f ? m.y : r.y; return o;
}

template <int ACT  > struct EpiBf16 {
    static constexpr bool PERM = true, AFTER_DRAIN = false; static_assert(ACT == 0 || ACT == 1, "EpiBf16: ACT is 0 (none) or 1 (gelu_pk)");
    bf16_t* O; int ldc; const float* bias; int split_cols; size_t split_stride; float scale0;
    __device__ __forceinline__ void operator()(const f32x4 (&acc)[2][2][4][2], const Unit& u, int wr, int wc, int fr, int fq) const {
        const int row0 = u.pm * BM + wr * 64 + fr; int colt = u.pn * BM; bf16_t* base = O;
        float sc = 1.f; if (split_cols) { const int t = colt / split_cols; base += (size_t)t * split_stride; colt -= t * split_cols; if (t == 0) sc = scale0; }
        const int col0 = colt + wc * 32 + 8 * fq, bcol0 = u.pn * BM + wc * 32 + 8 * fq;
        f32x4 bv[2][2];
#pragma unroll
        for (int bj = 0; bj < 2; ++bj)
#pragma unroll
            for (int n = 0; n < 2; ++n) bv[bj][n] = bias ? *(const PG8_GAS f32x4*)(bias + bcol0 + bj * HALF + 4 * n) : (f32x4){0.f, 0.f, 0.f, 0.f};
#pragma unroll
        for (int ai = 0; ai < 2; ++ai)
#pragma unroll
            for (int m = 0; m < 4; ++m) { bf16_t* rowp = base + (size_t)(row0 + ai * HALF + m * 16) * ldc + col0;
#pragma unroll
                for (int bj = 0; bj < 2; ++bj) { f32x4 v0 = acc[ai][bj][m][0] + bv[bj][0], v1 = acc[ai][bj][m][1] + bv[bj][1];
                    if (ACT == 1) { f32x2 a = gelu_pk((f32x2){v0[0], v0[1]}), b = gelu_pk((f32x2){v0[2], v0[3]}), c = gelu_pk((f32x2){v1[0], v1[1]}), d = gelu_pk((f32x2){v1[2], v1[3]});
                        v0 = (f32x4){a.x, a.y, b.x, b.y}; v1 = (f32x4){c.x, c.y, d.x, d.y}; }
                    v0 = v0 * sc; v1 = v1 * sc; u32x4 w; w.x = cvt_pk_bf16(v0[0], v0[1]); w.y = cvt_pk_bf16(v0[2], v0[3]); w.z = cvt_pk_bf16(v1[0], v1[1]); w.w = cvt_pk_bf16(v1[2], v1[3]);
                    *(PG8_GAS u32x4*)(rowp + bj * HALF) = w; } }
    }
};
struct EpiRes {
    static constexpr bool PERM = false, AFTER_DRAIN = false;
    const float* base; float* out; int ldc;
    __device__ __forceinline__ void operator()(const f32x4 (&acc)[2][2][4][2], const Unit& u, int wr, int wc, int fr, int fq) const {
        const int row0 = u.pm * BM + wr * 64 + fr, col0 = u.pn * BM + wc * 32 + 4 * fq;
#pragma unroll
        for (int ai = 0; ai < 2; ++ai) {
            f32x4 bs[4][2][2];
#pragma unroll
            for (int m = 0; m < 4; ++m) { const size_t off = (size_t)(row0 + ai * HALF + m * 16) * ldc + col0;
#pragma unroll
                for (int bj = 0; bj < 2; ++bj)
#pragma unroll
                    for (int n = 0; n < 2; ++n) bs[m][bj][n] = *(const f32x4*)(base + off + bj * HALF + n * 16); }
            asm volatile("" ::: "memory");
#pragma unroll
            for (int m = 0; m < 4; ++m) { const size_t off = (size_t)(row0 + ai * HALF + m * 16) * ldc + col0;
#pragma unroll
                for (int bj = 0; bj < 2; ++bj)
#pragma unroll
                    for (int n = 0; n < 2; ++n) *(f32x4*)(out + off + bj * HALF + n * 16) = bs[m][bj][n] + acc[ai][bj][m][n]; }
            asm volatile("" ::: "memory");
        }
    }
};
struct EpiGateMix {
    static constexpr bool PERM = false, AFTER_DRAIN = false;
    const unsigned char* BV; bf16_t* MIX; const unsigned long long* ss;
    __device__ __forceinline__ void operator()(const f32x4 (&acc)[2][2][4][2], const Unit& u, int wr, int wc, int fr, int fq) const {
        typedef unsigned u32x2 __attribute__((ext_vector_type(2)));
        const int row0 = u.pm * BM + wr * 64 + fr, ncol = u.pn * 64 + wc * 16 + 4 * fq;
        unsigned long long ssr[2][4];
#pragma unroll
        for (int ai = 0; ai < 2; ++ai)
#pragma unroll
            for (int m = 0; m < 4; ++m) ssr[ai][m] = ((const PG8_GAS unsigned long long*)ss)[row0 + ai * HALF + m * 16];
        u32x4 raw[4][2]; float scl[4];
        {   const int g = ((u.pn & 3) * 2 + wr) * 4 + wc, l = fq * 16 + fr;
#pragma unroll
            for (int i = 0; i < 4; ++i) { const unsigned char* tile = BV + (size_t)(u.pm * 16 + 4 * i + (u.pn >> 2)) * 73728;
                raw[i][0] = *(const PG8_GAS u32x4*)(tile + (size_t)((2 * g) * 64 + l) * 16); raw[i][1] = *(const PG8_GAS u32x4*)(tile + (size_t)((2 * g + 1) * 64 + l) * 16);
                scl[i] = *(const PG8_GAS float*)(tile + 65536 + (size_t)(64 * g + l) * 4); } }
        asm volatile("" ::: "memory");
        float nsc[4];
#pragma unroll
        for (int i = 0; i < 4; ++i) nsc[i] = -128.0f * scl[i];
#pragma unroll
        for (int ai = 0; ai < 2; ++ai)
#pragma unroll
            for (int m = 0; m < 4; ++m) { const size_t row = (size_t)(row0 + ai * HALF + m * 16);
                const float nrl = -46.16624130844683f * __builtin_amdgcn_rsqf((float)ssr[ai][m] * (1.0f / 65536.0f) + 1024.0e-6f);
                f32x4 sum = (f32x4){0.f, 0.f, 0.f, 0.f};
#pragma unroll
                for (int i = 0; i < 4; ++i) { const f32x4 gte = acc[ai][i >> 1][m][i & 1]; const unsigned rw = raw[i][ai][m];
                    f32x4 bv; bv[0] = fmaf((float)(rw & 0xffu), scl[i], nsc[i]); bv[1] = fmaf((float)((rw >> 8) & 0xffu), scl[i], nsc[i]); bv[2] = fmaf((float)((rw >> 16) & 0xffu), scl[i], nsc[i]); bv[3] = fmaf((float)(rw >> 24), scl[i], nsc[i]);
#pragma unroll
                    for (int e = 0; e < 4; ++e) { const float sg = __builtin_amdgcn_rcpf(1.0f + __builtin_amdgcn_exp2f(nrl * gte[e])); sum[e] += sg * bv[e]; } }
                u32x2 w; w.x = cvt_pk_bf16(sum[0], sum[1]); w.y = cvt_pk_bf16(sum[2], sum[3]);
                *(PG8_GAS u32x2*)(MIX + row * 1024 + ncol) = w; }
    }
};
struct EpiGateMix8 {
    static constexpr bool PERM = false, AFTER_DRAIN = false;
    const unsigned char* BV; bf16_t* MIX; const float* ss; const float* sx; const unsigned* wmax;
    __device__ __forceinline__ void operator()(const int __attribute__((ext_vector_type(4))) (&acc)[2][2][4][2], const Unit& u, int wr, int wc, int fr, int fq) const {
        typedef unsigned u32x2 __attribute__((ext_vector_type(2)));
        const int row0 = u.pm * BM + wr * 64 + fr, ncol = u.pn * 64 + wc * 16 + 4 * fq;
        float ssr[2][4]; float sxr[2][4];
#pragma unroll
        for (int ai = 0; ai < 2; ++ai)
#pragma unroll
            for (int m = 0; m < 4; ++m) { ssr[ai][m] = ((const PG8_GAS float*)ss)[row0 + ai * HALF + m * 16]; sxr[ai][m] = ((const PG8_GAS float*)sx)[row0 + ai * HALF + m * 16]; }
        const unsigned* wmp = wmax; asm volatile("" : "+v"(wmp));
        const float sw = __uint_as_float(*(const PG8_GAS unsigned*)wmp) * (-46.16624130844683f / 127.0f);
        u32x4 raw[4][2]; float scl[4];
        {   const int g = ((u.pn & 3) * 2 + wr) * 4 + wc, l = fq * 16 + fr;
#pragma unroll
            for (int i = 0; i < 4; ++i) { const unsigned char* tile = BV + (size_t)(u.pm * 16 + 4 * i + (u.pn >> 2)) * 73728;
                raw[i][0] = *(const PG8_GAS u32x4*)(tile + (size_t)((2 * g) * 64 + l) * 16); raw[i][1] = *(const PG8_GAS u32x4*)(tile + (size_t)((2 * g + 1) * 64 + l) * 16);
                scl[i] = *(const PG8_GAS float*)(tile + 65536 + (size_t)(64 * g + l) * 4); } }
        asm volatile("" ::: "memory");
        float nsc[4];
#pragma unroll
        for (int i = 0; i < 4; ++i) nsc[i] = -128.0f * scl[i];
#pragma unroll
        for (int ai = 0; ai < 2; ++ai)
#pragma unroll
            for (int m = 0; m < 4; ++m) { const size_t row = (size_t)(row0 + ai * HALF + m * 16);
                const float nrl = sw * sxr[ai][m] * __builtin_amdgcn_rsqf(ssr[ai][m] + 1024.0e-6f);
                f32x4 sum = (f32x4){0.f, 0.f, 0.f, 0.f};
#pragma unroll
                for (int i = 0; i < 4; ++i) { const auto gti = acc[ai][i >> 1][m][i & 1]; const f32x4 gte = (f32x4){(float)gti[0], (float)gti[1], (float)gti[2], (float)gti[3]}; const unsigned rw = raw[i][ai][m];
                    f32x4 bv; bv[0] = fmaf((float)(rw & 0xffu), scl[i], nsc[i]); bv[1] = fmaf((float)((rw >> 8) & 0xffu), scl[i], nsc[i]); bv[2] = fmaf((float)((rw >> 16) & 0xffu), scl[i], nsc[i]); bv[3] = fmaf((float)(rw >> 24), scl[i], nsc[i]);
#pragma unroll
                    for (int e = 0; e < 4; ++e) { const float sg = __builtin_amdgcn_rcpf(1.0f + __builtin_amdgcn_exp2f(nrl * gte[e])); sum[e] = __builtin_fmaf(sg, bv[e], sum[e]); } }
                u32x2 w; w.x = cvt_pk_bf16(sum[0], sum[1]); w.y = cvt_pk_bf16(sum[2], sum[3]);
                *(PG8_GAS u32x2*)(MIX + row * 1024 + ncol) = w; }
    }
};

#define PG8_DPPF(x, ctrl) __builtin_bit_cast(float, __builtin_amdgcn_update_dpp(0, __builtin_bit_cast(int, (x)), (ctrl), 0xf, 0xf, true))
struct EpiConvGelu {
    static constexpr bool PERM = true, AFTER_DRAIN = false;
    bf16_t* ACT; bf16_t* HALO; const float* cw; const float* cb; const unsigned long long* ss;
    __device__ __forceinline__ void operator()(const f32x4 (&acc_)[2][2][4][2], const Unit& u, int wr, int wc, int fr, int fq) const {
        typedef unsigned u32x2 __attribute__((ext_vector_type(2)));
        constexpr int NF = 2816, NU = 5632;
        const int row0 = u.pm * BM + wr * 64 + fr;
        f32x4 (&acc)[2][2][4][2] = const_cast<f32x4 (&)[2][2][4][2]>(acc_);
#pragma unroll
        for (int ai = 0; ai < 2; ++ai)
#pragma unroll
            for (int m = 0; m < 4; ++m) { const float r = 32.0f * __builtin_amdgcn_rsqf((float)((const PG8_GAS unsigned long long*)ss)[row0 + ai * HALF + m * 16] * (1.0f / 65536.0f) + 1024.0e-6f);
#pragma unroll
                for (int bj = 0; bj < 2; ++bj)
#pragma unroll
                    for (int n = 0; n < 2; ++n) acc[ai][bj][m][n] = acc[ai][bj][m][n] * r; }
        u32x2 keep[2][4];
#pragma unroll
        for (int n = 0; n < 2; ++n) {
            const int f = u.pn * 128 + wc * 32 + 8 * fq + 4 * n;
            const f32x4 wg0 = *(const PG8_GAS f32x4*)(cw + f), wg1 = *(const PG8_GAS f32x4*)(cw + NU + f), wg2 = *(const PG8_GAS f32x4*)(cw + 2 * NU + f), bg = *(const PG8_GAS f32x4*)(cb + f);
            const f32x4 wu0 = *(const PG8_GAS f32x4*)(cw + NF + f), wu1 = *(const PG8_GAS f32x4*)(cw + NU + NF + f), wu2 = *(const PG8_GAS f32x4*)(cw + 2 * NU + NF + f), bu = *(const PG8_GAS f32x4*)(cb + NF + f);
#pragma unroll
            for (int ai = 0; ai < 2; ++ai) {
                {   const int chunk = (u.pm * BM + ai * HALF + wr * 64) >> 6;
                    if (fr < 2) { bf16_t* hp = HALO + ((size_t)chunk * 4 + fr) * NU + f; const f32x4 g = acc[ai][0][0][n], uu = acc[ai][1][0][n];
                        u32x2 a, b; a.x = cvt_pk_bf16(g[0], g[1]); a.y = cvt_pk_bf16(g[2], g[3]); b.x = cvt_pk_bf16(uu[0], uu[1]); b.y = cvt_pk_bf16(uu[2], uu[3]);
                        *(PG8_GAS u32x2*)hp = a; *(PG8_GAS u32x2*)(hp + NF) = b; }
                    if (fr >= 14) { bf16_t* hp = HALO + ((size_t)chunk * 4 + (fr - 12)) * NU + f; const f32x4 g = acc[ai][0][3][n], uu = acc[ai][1][3][n];
                        u32x2 a, b; a.x = cvt_pk_bf16(g[0], g[1]); a.y = cvt_pk_bf16(g[2], g[3]); b.x = cvt_pk_bf16(uu[0], uu[1]); b.y = cvt_pk_bf16(uu[2], uu[3]);
                        *(PG8_GAS u32x2*)hp = a; *(PG8_GAS u32x2*)(hp + NF) = b; } }
#pragma unroll
                for (int m = 0; m < 4; ++m) {
                    f32x4 cg, cu;
#pragma unroll
                    for (int e = 0; e < 4; ++e) {
                        const float g = acc[ai][0][m][n][e], uu = acc[ai][1][m][n][e];
                        float a = bg[e] + wg2[e] * g; a = fmaf(wg1[e], PG8_DPPF(g, 0x111), a); a = fmaf(wg0[e], PG8_DPPF(g, 0x112), a);
                        float b = bu[e] + wu2[e] * uu; b = fmaf(wu1[e], PG8_DPPF(uu, 0x111), b); b = fmaf(wu0[e], PG8_DPPF(uu, 0x112), b);
                        if (m > 0) { const float gp = acc[ai][0][m - 1][n][e], up = acc[ai][1][m - 1][n][e];
                            a = fmaf(wg1[e], PG8_DPPF(gp, 0x10f), a); a = fmaf(wg0[e], PG8_DPPF(gp, 0x10e), a);
                            b = fmaf(wu1[e], PG8_DPPF(up, 0x10f), b); b = fmaf(wu0[e], PG8_DPPF(up, 0x10e), b); }
                        cg[e] = a; cu[e] = b; }
                    const f32x2 ga = gelu_pk((f32x2){cg[0], cg[1]}), gb = gelu_pk((f32x2){cg[2], cg[3]});
                    u32x2 w; w.x = cvt_pk_bf16(ga.x * cu[0], ga.y * cu[1]); w.y = cvt_pk_bf16(gb.x * cu[2], gb.y * cu[3]);
                    if (n == 0) keep[ai][m] = w;
                    else { u32x4 o; o.x = keep[ai][m].x; o.y = keep[ai][m].y; o.z = w.x; o.w = w.y; *(PG8_GAS u32x4*)(ACT + (((size_t)u.pm * (NF / 64) + ((f - 4) >> 6)) * 256 + (wr * 64 + fr + ai * HALF + m * 16)) * 64 + ((f - 4) & 63)) = o; } }
            }
        }
    }
};

struct EpiConvGelu8 {
    static constexpr bool PERM = true, AFTER_DRAIN = false;
    bf16_t* ACT; bf16_t* HALO; const float* cw; const float* cb; const float* ss; const float* sx; const float* cmax;
    __device__ __forceinline__ void operator()(const int __attribute__((ext_vector_type(4))) (&acc_)[2][2][4][2], const Unit& u, int wr, int wc, int fr, int fq) const {
        typedef unsigned u32x2 __attribute__((ext_vector_type(2)));
        constexpr int NF = 2816, NU = 5632;
        const int row0 = u.pm * BM + wr * 64 + fr;
        f32x4 acc[2][2][4][2];
        const float sw = 32.0f;
#pragma unroll
        for (int ai = 0; ai < 2; ++ai)
#pragma unroll
            for (int m = 0; m < 4; ++m) { const float r = sw * ((const PG8_GAS float*)sx)[row0 + ai * HALF + m * 16] * __builtin_amdgcn_rsqf(((const PG8_GAS float*)ss)[row0 + ai * HALF + m * 16] + 1024.0e-6f);
#pragma unroll
                for (int bj = 0; bj < 2; ++bj)
#pragma unroll
                    for (int n = 0; n < 2; ++n) { const auto t = acc_[ai][bj][m][n]; acc[ai][bj][m][n] = (f32x4){(float)t[0], (float)t[1], (float)t[2], (float)t[3]} * r; } }
        u32x2 keep[2][4];
#pragma unroll
        for (int n = 0; n < 2; ++n) {
            const int f = u.pn * 128 + wc * 32 + 8 * fq + 4 * n;
            const f32x4 swg = *(const PG8_GAS f32x4*)(cmax + f) * (1.0f / 127.0f), swu = *(const PG8_GAS f32x4*)(cmax + NF + f) * (1.0f / 127.0f);
            const f32x4 wg0 = *(const PG8_GAS f32x4*)(cw + f) * swg, wg1 = *(const PG8_GAS f32x4*)(cw + NU + f) * swg, wg2 = *(const PG8_GAS f32x4*)(cw + 2 * NU + f) * swg, bg = *(const PG8_GAS f32x4*)(cb + f);
            const f32x4 wu0 = *(const PG8_GAS f32x4*)(cw + NF + f) * swu, wu1 = *(const PG8_GAS f32x4*)(cw + NU + NF + f) * swu, wu2 = *(const PG8_GAS f32x4*)(cw + 2 * NU + NF + f) * swu, bu = *(const PG8_GAS f32x4*)(cb + NF + f);
#pragma unroll
            for (int ai = 0; ai < 2; ++ai) {
                {   const int chunk = (u.pm * BM + ai * HALF + wr * 64) >> 6;
                    if (fr < 2) { bf16_t* hp = HALO + ((size_t)chunk * 4 + fr) * NU + f; const f32x4 g = acc[ai][0][0][n], uu = acc[ai][1][0][n];
                        u32x2 a, b; a.x = cvt_pk_bf16(g[0], g[1]); a.y = cvt_pk_bf16(g[2], g[3]); b.x = cvt_pk_bf16(uu[0], uu[1]); b.y = cvt_pk_bf16(uu[2], uu[3]);
                        *(PG8_GAS u32x2*)hp = a; *(PG8_GAS u32x2*)(hp + NF) = b; }
                    if (fr >= 14) { bf16_t* hp = HALO + ((size_t)chunk * 4 + (fr - 12)) * NU + f; const f32x4 g = acc[ai][0][3][n], uu = acc[ai][1][3][n];
                        u32x2 a, b; a.x = cvt_pk_bf16(g[0], g[1]); a.y = cvt_pk_bf16(g[2], g[3]); b.x = cvt_pk_bf16(uu[0], uu[1]); b.y = cvt_pk_bf16(uu[2], uu[3]);
                        *(PG8_GAS u32x2*)hp = a; *(PG8_GAS u32x2*)(hp + NF) = b; } }
#pragma unroll
                for (int m = 0; m < 4; ++m) {
#define PG8_TAP8(CTRL, G, U, WG, WU) asm("s_nop 1\n\t" \
                        "v_fmac_f32_dpp %0, %8, %16 " CTRL " row_mask:0xf bank_mask:0xf bound_ctrl:1\n\tv_fmac_f32_dpp %1, %9, %17 " CTRL " row_mask:0xf bank_mask:0xf bound_ctrl:1\n\t" \
                        "v_fmac_f32_dpp %2, %10, %18 " CTRL " row_mask:0xf bank_mask:0xf bound_ctrl:1\n\tv_fmac_f32_dpp %3, %11, %19 " CTRL " row_mask:0xf bank_mask:0xf bound_ctrl:1\n\t" \
                        "v_fmac_f32_dpp %4, %12, %20 " CTRL " row_mask:0xf bank_mask:0xf bound_ctrl:1\n\tv_fmac_f32_dpp %5, %13, %21 " CTRL " row_mask:0xf bank_mask:0xf bound_ctrl:1\n\t" \
                        "v_fmac_f32_dpp %6, %14, %22 " CTRL " row_mask:0xf bank_mask:0xf bound_ctrl:1\n\tv_fmac_f32_dpp %7, %15, %23 " CTRL " row_mask:0xf bank_mask:0xf bound_ctrl:1" \
                        : "+v"(ca0), "+v"(ca1), "+v"(ca2), "+v"(ca3), "+v"(cb0), "+v"(cb1), "+v"(cb2), "+v"(cb3) \
                        : "v"(G[0]), "v"(G[1]), "v"(G[2]), "v"(G[3]), "v"(U[0]), "v"(U[1]), "v"(U[2]), "v"(U[3]), "v"(WG[0]), "v"(WG[1]), "v"(WG[2]), "v"(WG[3]), "v"(WU[0]), "v"(WU[1]), "v"(WU[2]), "v"(WU[3]))
                    f32x4 cg, cu;
                    {   const f32x4 gv = acc[ai][0][m][n], uv = acc[ai][1][m][n];
                        const f32x4 ia = bg + wg2 * gv, ib = bu + wu2 * uv;
                        float ca0 = ia[0], ca1 = ia[1], ca2 = ia[2], ca3 = ia[3], cb0 = ib[0], cb1 = ib[1], cb2 = ib[2], cb3 = ib[3];
                        PG8_TAP8("row_shr:1", gv, uv, wg1, wu1); PG8_TAP8("row_shr:2", gv, uv, wg0, wu0);
                        if (m > 0) { const f32x4 gp = acc[ai][0][m - 1][n], up = acc[ai][1][m - 1][n];
                            PG8_TAP8("row_shl:15", gp, up, wg1, wu1); PG8_TAP8("row_shl:14", gp, up, wg0, wu0); }
                        cg = (f32x4){ca0, ca1, ca2, ca3}; cu = (f32x4){cb0, cb1, cb2, cb3}; }
#undef PG8_TAP8
                    const f32x2 ga = gelu_pk((f32x2){cg[0], cg[1]}), gb = gelu_pk((f32x2){cg[2], cg[3]});
                    u32x2 w; w.x = cvt_pk_bf16(ga.x * cu[0], ga.y * cu[1]); w.y = cvt_pk_bf16(gb.x * cu[2], gb.y * cu[3]);
                    if (n == 0) keep[ai][m] = w;
                    else { u32x4 o; o.x = keep[ai][m].x; o.y = keep[ai][m].y; o.z = w.x; o.w = w.y; *(PG8_GAS u32x4*)(ACT + (((size_t)u.pm * (NF / 64) + ((f - 4) >> 6)) * 256 + (wr * 64 + fr + ai * HALF + m * 16)) * 64 + ((f - 4) & 63)) = o; } }
            }
        }
    }
};

struct EpiNull {
    static constexpr bool PERM = true, AFTER_DRAIN = false;
    __device__ __forceinline__ void operator()(const f32x4 (&acc)[2][2][4][2], const Unit& u, int wr, int wc, int fr, int fq) const {
#pragma unroll
        for (int ai = 0; ai < 2; ++ai)
#pragma unroll
            for (int bj = 0; bj < 2; ++bj)
#pragma unroll
                for (int m = 0; m < 4; ++m) asm volatile("" :: "v"(acc[ai][bj][m][0]), "v"(acc[ai][bj][m][1]));
    }
};

struct EpiBf16T {
    static constexpr bool PERM = true, AFTER_DRAIN = false;
    bf16_t* O; int ldc; PG8_LAS unsigned char* stg;
    __device__ __forceinline__ void operator()(const f32x4 (&acc)[2][2][4][2], const Unit& u, int wr, int wc, int fr, int fq) const {
        int fr_ = fr, fq_ = fq; asm volatile("" : "+v"(fr_), "+v"(fq_));
        const int lane = fq_ * 16 + fr_; PG8_LAS unsigned char* my = stg + (wr * 4 + wc) * 1280;
        PG8_LAS u32x4* wp = (PG8_LAS u32x4*)(my + fr_ * 80 + fq_ * 16); const PG8_LAS u32x4* rp = (const PG8_LAS u32x4*)(my + (lane >> 2) * 80 + (lane & 3) * 16);
        bf16_t* ob = O + (size_t)(u.pm * BM + wr * 64 + (lane >> 2)) * ldc + u.pn * BM + wc * 32 + (lane & 3) * 8;
#pragma unroll
        for (int ai = 0; ai < 2; ++ai)
#pragma unroll
            for (int m = 0; m < 4; ++m)
#pragma unroll
                for (int bj = 0; bj < 2; ++bj) { const f32x4 v0 = acc[ai][bj][m][0], v1 = acc[ai][bj][m][1];
                    u32x4 w; w.x = cvt_pk_bf16(v0[0], v0[1]); w.y = cvt_pk_bf16(v0[2], v0[3]); w.z = cvt_pk_bf16(v1[0], v1[1]); w.w = cvt_pk_bf16(v1[2], v1[3]);
                    *wp = w; asm volatile("s_waitcnt lgkmcnt(0)" ::: "memory");
                    const u32x4 t = *rp; asm volatile("s_waitcnt lgkmcnt(0)" ::: "memory");
                    *(u32x4*)(ob + (size_t)(ai * HALF + m * 16) * ldc + bj * HALF) = t; }
    }
};

struct EpiProj3 {
    static constexpr bool PERM = true, AFTER_DRAIN = false;
    bf16_t* O; size_t split_stride;
    __device__ __forceinline__ void operator()(const f32x4 (&acc)[2][2][4][2], const Unit& u, int wr, int wc, int fr, int fq) const {
        const int row0 = u.pm * BM + wr * 64 + fr; const int colt = u.pn * BM; const int t = colt >> 10;
        bf16_t* base = O + (size_t)t * split_stride + (size_t)row0 * 1024 + ((colt & 1023) + wc * 32 + 8 * fq);
#pragma unroll
        for (int ai = 0; ai < 2; ++ai)
#pragma unroll
            for (int m = 0; m < 4; ++m)
#pragma unroll
                for (int bj = 0; bj < 2; ++bj) { const f32x4 v0 = acc[ai][bj][m][0], v1 = acc[ai][bj][m][1];
                    u32x4 w; w.x = cvt_pk_bf16(v0[0], v0[1]); w.y = cvt_pk_bf16(v0[2], v0[3]); w.z = cvt_pk_bf16(v1[0], v1[1]); w.w = cvt_pk_bf16(v1[2], v1[3]);
                    *(u32x4*)(base + (size_t)(ai * HALF + m * 16) * 1024 + bj * HALF) = w; }
    }
};

struct EpiHalf {
    static constexpr bool PERM = true, AFTER_DRAIN = false;
    bf16_t* O; int ldc;
    __device__ __forceinline__ void operator()(const f32x4 (&acc)[2][2][4][2], const Unit& u, int wr, int wc, int fr, int fq) const {
        bf16_t* base = O + (size_t)(u.pm * BM + wr * 64 + fr) * ldc + u.pn * BM + wc * 32 + 8 * fq;
#pragma unroll
        for (int m = 0; m < 4; ++m)
#pragma unroll
            for (int bj = 0; bj < 2; ++bj) { const f32x4 v0 = acc[0][bj][m][0], v1 = acc[0][bj][m][1];
                u32x4 w; w.x = cvt_pk_bf16(v0[0], v0[1]); w.y = cvt_pk_bf16(v0[2], v0[3]); w.z = cvt_pk_bf16(v1[0], v1[1]); w.w = cvt_pk_bf16(v1[2], v1[3]);
                *(u32x4*)(base + (size_t)(m * 16) * ldc + bj * HALF) = w; }
#pragma unroll
        for (int bj = 0; bj < 2; ++bj)
#pragma unroll
            for (int m = 0; m < 4; ++m) asm volatile("" :: "v"(acc[1][bj][m][0]), "v"(acc[1][bj][m][1]));
    }
};

template <bool ATOM = true> struct EpiResBT {
    static constexpr bool PERM = true, AFTER_DRAIN = false;
    bf16_t* xb; int ldc; float* ss; PG8_LAS float* sq;
    __device__ __forceinline__ void operator()(const f32x4 (&acc)[2][2][4][2], const Unit& u, int wr, int wc, int fr, int fq) const {
        bf16_t* base = xb + (size_t)(u.pm * BM + wr * 64 + fr) * ldc + u.pn * BM + wc * 32 + 8 * fq;
#pragma unroll
        for (int ai = 0; ai < 2; ++ai) {
            u32x4 bs[4][2];
#pragma unroll
            for (int m = 0; m < 4; ++m)
#pragma unroll
                for (int bj = 0; bj < 2; ++bj) bs[m][bj] = *(const PG8_GAS u32x4*)(base + (size_t)(ai * HALF + m * 16) * ldc + bj * HALF);
            asm volatile("" ::: "memory");
#pragma unroll
            for (int m = 0; m < 4; ++m) { float sqv = 0.f;
#pragma unroll
                for (int bj = 0; bj < 2; ++bj) { const u32x4 r = bs[m][bj]; const f32x4 a0 = acc[ai][bj][m][0], a1 = acc[ai][bj][m][1];
                    const float x0 = __uint_as_float(r.x << 16) + a0[0], x1 = __uint_as_float(r.x & 0xffff0000u) + a0[1], x2 = __uint_as_float(r.y << 16) + a0[2], x3 = __uint_as_float(r.y & 0xffff0000u) + a0[3];
                    const float x4 = __uint_as_float(r.z << 16) + a1[0], x5 = __uint_as_float(r.z & 0xffff0000u) + a1[1], x6 = __uint_as_float(r.w << 16) + a1[2], x7 = __uint_as_float(r.w & 0xffff0000u) + a1[3];
                    sqv += ((x0 * x0 + x1 * x1) + (x2 * x2 + x3 * x3)) + ((x4 * x4 + x5 * x5) + (x6 * x6 + x7 * x7));
                    u32x4 w; w.x = cvt_pk_bf16(x0, x1); w.y = cvt_pk_bf16(x2, x3); w.z = cvt_pk_bf16(x4, x5); w.w = cvt_pk_bf16(x6, x7);
                    *(PG8_GAS u32x4*)(base + (size_t)(ai * HALF + m * 16) * ldc + bj * HALF) = w; }
                { auto r16 = __builtin_amdgcn_permlane16_swap(__float_as_uint(sqv), __float_as_uint(sqv), false, false); sqv = __uint_as_float(r16[0]) + __uint_as_float(r16[1]);
                  auto r32 = __builtin_amdgcn_permlane32_swap(__float_as_uint(sqv), __float_as_uint(sqv), false, false); sqv = __uint_as_float(r32[0]) + __uint_as_float(r32[1]); }
                if (ATOM && fq == 0) sq[wc * 256 + wr * 64 + fr + ai * HALF + m * 16] = sqv; }
            asm volatile("" ::: "memory");
        }
        if (ATOM) {
            asm volatile("s_waitcnt lgkmcnt(0)" ::: "memory"); __builtin_amdgcn_s_barrier();
            if (wr == 0) { const int t = wc * 64 + fq * 16 + fr;
                const float s4 = (sq[t] + sq[256 + t]) + (sq[512 + t] + sq[768 + t]);
                ((PG8_GAS float*)ss)[(size_t)(u.pm * BM + t) * 4 + u.pn] = s4; }
        }
    }
};
typedef EpiResBT<true> EpiResB;

struct EpiBvTile {
    static constexpr bool PERM = true, AFTER_DRAIN = false;
    bf16_t* BV;
    __device__ __forceinline__ void operator()(const f32x4 (&acc)[2][2][4][2], const Unit& u, int wr, int wc, int fr, int fq) const {
        int l_; asm volatile("v_mbcnt_lo_u32_b32 %0, -1, 0\n\tv_mbcnt_hi_u32_b32 %0, -1, %0" : "=v"(l_)); const int fr_ = l_ & 15, fq_ = l_ >> 4; (void)fr; (void)fq;
        bf16_t* base = BV + ((size_t)(u.pm * 16 + u.pn) * 256 + wr * 64 + fr_) * 256 + wc * 32 + 8 * fq_;
#pragma unroll
        for (int ai = 0; ai < 2; ++ai)
#pragma unroll
            for (int m = 0; m < 4; ++m)
#pragma unroll
                for (int bj = 0; bj < 2; ++bj) { const f32x4 v0 = acc[ai][bj][m][0], v1 = acc[ai][bj][m][1];
                    u32x4 w; w.x = cvt_pk_bf16(v0[0], v0[1]); w.y = cvt_pk_bf16(v0[2], v0[3]); w.z = cvt_pk_bf16(v1[0], v1[1]); w.w = cvt_pk_bf16(v1[2], v1[3]);
                    *(PG8_GAS u32x4*)(base + (size_t)(ai * HALF + m * 16) * 256 + bj * HALF) = w; }
    }
};

constexpr int BVQ_TILE = 65536 + 8192;
struct EpiBvQ8 {
    static constexpr bool PERM = false, AFTER_DRAIN = false;
    unsigned char* BV;
    __device__ __forceinline__ void operator()(const f32x4 (&acc)[2][2][4][2], const Unit& u, int wr, int wc, int fr, int fq) const {
        int l_; asm volatile("v_mbcnt_lo_u32_b32 %0, -1, 0\n\tv_mbcnt_hi_u32_b32 %0, -1, %0" : "=v"(l_)); (void)fr; (void)fq;
        unsigned char* tile = BV + (size_t)(u.pm * 16 + u.pn) * BVQ_TILE;
#pragma unroll
        for (int bj = 0; bj < 2; ++bj)
#pragma unroll
            for (int n = 0; n < 2; ++n) {
                const int g = ((2 * bj + (wc >> 1)) * 2 + wr) * 4 + 2 * (wc & 1) + n;
                float amax = 1.0e-30f;
#pragma unroll
                for (int ai = 0; ai < 2; ++ai)
#pragma unroll
                    for (int m = 0; m < 4; ++m) { const f32x4 v = acc[ai][bj][m][n]; amax = fmaxf(fmaxf(amax, fabsf(v[0])), fmaxf(fabsf(v[1]), fmaxf(fabsf(v[2]), fabsf(v[3])))); }
                const float inv = 127.0f * __builtin_amdgcn_rcpf(amax);
#pragma unroll
                for (int ai = 0; ai < 2; ++ai) { u32x4 w;
#pragma unroll
                    for (int m = 0; m < 4; ++m) { const f32x4 v = acc[ai][bj][m][n];
                        const unsigned b0 = __float_as_uint(fmaf(v[0], inv, 12583040.0f)), b1 = __float_as_uint(fmaf(v[1], inv, 12583040.0f)), b2 = __float_as_uint(fmaf(v[2], inv, 12583040.0f)), b3 = __float_as_uint(fmaf(v[3], inv, 12583040.0f));
                        w[m] = __builtin_amdgcn_perm(b1, b0, 0x0c0c0400u) | __builtin_amdgcn_perm(b3, b2, 0x04000c0cu); }
                    *(PG8_GAS u32x4*)(tile + ((size_t)((2 * g + ai) * 64 + l_)) * 16) = w; }
                *(PG8_GAS float*)(tile + 65536 + (size_t)(64 * g + l_) * 4) = amax * (1.0f / 127.0f);
            }
    }
};

struct EpiProjS {
    static constexpr bool PERM = true, AFTER_DRAIN = false;
    bf16_t* O; size_t split_stride; const float* ss;
    __device__ __forceinline__ void operator()(const f32x4 (&acc)[2][2][4][2], const Unit& u, int wr, int wc, int fr, int fq) const {
        const int row0 = u.pm * BM + wr * 64 + fr; const int colt = u.pn * BM; const int t = colt >> 10;
        bf16_t* base = O + (size_t)t * split_stride + (size_t)row0 * 1024 + ((colt & 1023) + wc * 32 + 8 * fq);
        f32x4 ssr[2][4];
#pragma unroll
        for (int ai = 0; ai < 2; ++ai)
#pragma unroll
            for (int m = 0; m < 4; ++m) ssr[ai][m] = ((const PG8_GAS f32x4*)ss)[row0 + ai * HALF + m * 16];
#pragma unroll
        for (int ai = 0; ai < 2; ++ai)
#pragma unroll
            for (int m = 0; m < 4; ++m) { const float r = 32.0f * __builtin_amdgcn_rsqf(((ssr[ai][m][0] + ssr[ai][m][1]) + (ssr[ai][m][2] + ssr[ai][m][3])) + 1024.0e-6f);
#pragma unroll
                for (int bj = 0; bj < 2; ++bj) { const f32x4 v0 = acc[ai][bj][m][0] * r, v1 = acc[ai][bj][m][1] * r;
                    u32x4 w; w.x = cvt_pk_bf16(v0[0], v0[1]); w.y = cvt_pk_bf16(v0[2], v0[3]); w.z = cvt_pk_bf16(v1[0], v1[1]); w.w = cvt_pk_bf16(v1[2], v1[3]);
                    *(PG8_GAS u32x4*)(base + (size_t)(ai * HALF + m * 16) * 1024 + bj * HALF) = w; } }
    }
};

struct EpiProjS8 {
    static constexpr bool PERM = true, AFTER_DRAIN = false;
    bf16_t* O; size_t split_stride; const float* ss; const float* sx; const float* sw;
    __device__ __forceinline__ void operator()(const int __attribute__((ext_vector_type(4))) (&acc)[2][2][4][2], const Unit& u, int wr, int wc, int fr, int fq) const {
        const int row0 = u.pm * BM + wr * 64 + fr; const int colt = u.pn * BM; const int t = colt >> 10;
        bf16_t* base = O + (size_t)t * split_stride + (size_t)row0 * 1024 + ((colt & 1023) + wc * 32 + 8 * fq);
        float ssr[2][4], sxr[2][4]; f32x4 cw[2][2];
#pragma unroll
        for (int ai = 0; ai < 2; ++ai)
#pragma unroll
            for (int m = 0; m < 4; ++m) { ssr[ai][m] = ((const PG8_GAS float*)ss)[row0 + ai * HALF + m * 16]; sxr[ai][m] = ((const PG8_GAS float*)sx)[row0 + ai * HALF + m * 16]; }
#pragma unroll
        for (int bj = 0; bj < 2; ++bj)
#pragma unroll
            for (int n = 0; n < 2; ++n) cw[bj][n] = *(const PG8_GAS f32x4*)(sw + colt + wc * 32 + 8 * fq + bj * HALF + 4 * n);
#pragma unroll
        for (int ai = 0; ai < 2; ++ai)
#pragma unroll
            for (int m = 0; m < 4; ++m) { const float r = 32.0f * sxr[ai][m] * __builtin_amdgcn_rsqf(ssr[ai][m] + 1024.0e-6f);
#pragma unroll
                for (int bj = 0; bj < 2; ++bj) { const auto i0 = acc[ai][bj][m][0], i1 = acc[ai][bj][m][1];
                    const f32x4 v0 = (f32x4){(float)i0[0], (float)i0[1], (float)i0[2], (float)i0[3]} * r * cw[bj][0], v1 = (f32x4){(float)i1[0], (float)i1[1], (float)i1[2], (float)i1[3]} * r * cw[bj][1];
                    u32x4 w; w.x = cvt_pk_bf16(v0[0], v0[1]); w.y = cvt_pk_bf16(v0[2], v0[3]); w.z = cvt_pk_bf16(v1[0], v1[1]); w.w = cvt_pk_bf16(v1[2], v1[3]);
                    *(PG8_GAS u32x4*)(base + (size_t)(ai * HALF + m * 16) * 1024 + bj * HALF) = w; } }
    }
};
typedef int i32x4 __attribute__((ext_vector_type(4)));
template <bool B, class T, class U> struct pg8_cond { typedef T type; };
template <class T, class U> struct pg8_cond<false, T, U> { typedef U type; };
template <class T> __device__ __forceinline__ T pg8_zero4() { T t; t[0] = 0; t[1] = 0; t[2] = 0; t[3] = 0; return t; }
template <class Epi, class Sched, bool ALIGN_EPI = false, bool SP2 = false, bool I8 = false>
__device__ __forceinline__ void gemm_phase(PG8_LAS unsigned char* lds, const Gemm g, const Sched& S, const Epi& E, int tid_in) {
    int tid_ = tid_in; asm volatile("" : "+v"(tid_));
    const int tid = tid_, wid = __builtin_amdgcn_readfirstlane(tid >> 6), lane = tid & 63, wr = wid >> 2, wc = wid & 3, fr = lane & 15, fq = lane >> 4;
    const int K = g.K, nt = K / BK;
    unsigned voffA[2], voffB[2];
#pragma unroll
    for (int i = 0; i < 2; ++i) { int R, C; stage_rc(tid * 16 + i * 8192, R, C); const int Rb = Epi::PERM ? ((R & ~31) + perm32(R & 31)) : R;
        voffA[i] = (unsigned)(R * g.lda + C) * 2u; voffB[i] = (unsigned)(Rb * K + C) * 2u; }
    const size_t kstep = (size_t)(BK * 2);
    const size_t hstepA = (size_t)HALF * g.lda * 2, hstepB = (size_t)HALF * K * 2;
    const size_t tstepA = g.tstepA ? g.tstepA : 2 * hstepA, tstepB = 2 * hstepB;
    const size_t kstepA = g.kstepA ? g.kstepA : kstep;
#define PG8_AOFF(u) ((size_t)(u).pm * tstepA + (g.a_sh >= 0 ? (size_t)((u).pn >> g.a_sh) * (size_t)K * 2 : (size_t)0))
    const unsigned ldsw = (unsigned)wid * 1024u;
    const int aoff = lds_byte(wr * 64 + fr, fq * 8), boff = lds_byte(wc * 32 + fr, fq * 8);
#define PG8_SA(b, h) (((b) * 2 + (h)) * HTB)
#define PG8_SB(b, h) ((4 + (b) * 2 + (h)) * HTB)
#define PG8_STAGE(bufoff, gbase, voff) do { _Pragma("unroll") for (int _i = 0; _i < 2; ++_i) \
        __builtin_amdgcn_global_load_lds((const unsigned*)((const char*)(gbase) + (voff)[_i]), (PG8_LAS unsigned*)(lds + (bufoff) + ldsw + _i * 8192), 16, 0, 0); } while (0)
#define PG8_LDA(dst, b, h) do { _Pragma("unroll") for (int m = 0; m < 4; ++m) _Pragma("unroll") for (int k = 0; k < 2; ++k) dst[m][k] = *(const PG8_LAS bf16x8*)(lds + PG8_SA(b, h) + aoff + m * 2048 + k * 1024); } while (0)
#define PG8_LDB(dst, b, h) do { _Pragma("unroll") for (int n = 0; n < 2; ++n) _Pragma("unroll") for (int k = 0; k < 2; ++k) dst[n][k] = *(const PG8_LAS bf16x8*)(lds + PG8_SB(b, h) + boff + n * 2048 + k * 1024); } while (0)
#define PG8_MMA(ai, bj, At, Bt) do { __builtin_amdgcn_s_setprio(1); _Pragma("unroll") for (int m = 0; m < 4; ++m) _Pragma("unroll") for (int n = 0; n < 2; ++n) _Pragma("unroll") for (int k = 0; k < 2; ++k) \
        { if constexpr (I8) acc[ai][bj][m][n] = __builtin_amdgcn_mfma_i32_16x16x64_i8(__builtin_bit_cast(i32x4, Bt[n][k]), __builtin_bit_cast(i32x4, At[m][k]), acc[ai][bj][m][n], 0, 0, 0); \
          else acc[ai][bj][m][n] = __builtin_amdgcn_mfma_f32_16x16x32_bf16(Bt[n][k], At[m][k], acc[ai][bj][m][n], 0, 0, 0); } __builtin_amdgcn_s_setprio(0); } while (0)
#define PG8_WAIT_V(n) asm volatile("s_waitcnt vmcnt(" #n ")" ::: "memory")
#define PG8_WAIT_L(n) asm volatile("s_waitcnt lgkmcnt(" #n ")" ::: "memory")
#define PG8_BAR __builtin_amdgcn_s_barrier()
#define PG8_SCHED __builtin_amdgcn_sched_barrier(0)
    Unit cur, nxt; int ui = 0;
    if (!S.next(0, cur)) return;
    typedef typename pg8_cond<I8, i32x4, f32x4>::type acc_t;
    acc_t acc[2][2][4][2];
#pragma unroll
    for (int a = 0; a < 2; ++a)
#pragma unroll
        for (int b = 0; b < 2; ++b)
#pragma unroll
            for (int m = 0; m < 4; ++m)
#pragma unroll
                for (int n = 0; n < 2; ++n) acc[a][b][m][n] = pg8_zero4<acc_t>();
    bf16x8 At[4][2], B0[2][2], B1[2][2];
    const char* cA = (const char*)g.A + PG8_AOFF(cur); const char* cB = (const char*)g.Bt + (size_t)cur.pn * tstepB;
    S.a_ready(cur);
    if constexpr (SP2) {
        PG8_STAGE(PG8_SB(0, 0), cB, voffB); PG8_STAGE(PG8_SB(0, 1), cB + hstepB, voffB); PG8_STAGE(PG8_SA(0, 0), cA, voffA); PG8_STAGE(PG8_SA(0, 1), cA + hstepA, voffA);
        if (wr == 1) PG8_BAR;
        PG8_WAIT_V(2); PG8_BAR;
        PG8_STAGE(PG8_SB(1, 0), cB + kstep, voffB); PG8_STAGE(PG8_SA(1, 0), cA + kstepA, voffA); PG8_STAGE(PG8_SB(1, 1), cB + hstepB + kstep, voffB);
        PG8_WAIT_V(6); PG8_BAR;
    } else {
        PG8_STAGE(PG8_SB(0, 0), cB, voffB); PG8_STAGE(PG8_SA(0, 0), cA, voffA); PG8_STAGE(PG8_SB(0, 1), cB + hstepB, voffB); PG8_STAGE(PG8_SA(0, 1), cA + hstepA, voffA);
        if (wr == 1) PG8_BAR;
        PG8_WAIT_V(4); PG8_BAR;
        PG8_STAGE(PG8_SB(1, 0), cB + kstep, voffB); PG8_STAGE(PG8_SA(1, 0), cA + kstepA, voffA); PG8_STAGE(PG8_SB(1, 1), cB + hstepB + kstep, voffB);
        PG8_WAIT_V(6); PG8_BAR;
    }
    for (;;) {
        const bool has_next = S.next(ui + 1, nxt);
        const char* nA = has_next ? (const char*)g.A + PG8_AOFF(nxt) : cA; const char* nB = has_next ? (const char*)g.Bt + (size_t)nxt.pn * tstepB : cB;
        for (int t = 0; t < nt; t += 2) {
            const bool last = (t == nt - 2);
            const char* a1 = cA + (size_t)(t + 1) * kstepA;
            const char* a2 = last ? nA : cA + (size_t)(t + 2) * kstepA; const char* b2 = last ? nB : cB + (size_t)(t + 2) * kstep;
            const char* a3 = a2 + kstepA; const char* b3 = b2 + kstep;
            if (last && has_next) S.a_ready(nxt);
            if constexpr (SP2) {
            PG8_LDB(B0, 0, 0); PG8_LDB(B1, 0, 1); PG8_SCHED; PG8_LDA(At, 0, 0); PG8_STAGE(PG8_SA(1, 1), a1 + hstepA, voffA);
            PG8_WAIT_V(8); PG8_WAIT_L(0); PG8_BAR; PG8_MMA(0, 0, At, B0); PG8_MMA(0, 1, At, B1); PG8_BAR; PG8_SCHED;
            PG8_LDA(At, 0, 1); PG8_STAGE(PG8_SB(0, 0), b2, voffB); PG8_STAGE(PG8_SB(0, 1), b2 + hstepB, voffB); PG8_STAGE(PG8_SA(0, 0), a2, voffA);
            PG8_WAIT_V(8); PG8_WAIT_L(0); PG8_BAR; PG8_MMA(1, 0, At, B0); PG8_MMA(1, 1, At, B1); PG8_BAR; PG8_SCHED;
            PG8_LDB(B0, 1, 0); PG8_LDB(B1, 1, 1); PG8_SCHED; PG8_LDA(At, 1, 0); PG8_STAGE(PG8_SA(0, 1), a2 + hstepA, voffA);
            PG8_WAIT_V(8); PG8_WAIT_L(0); PG8_BAR; PG8_MMA(0, 0, At, B0); PG8_MMA(0, 1, At, B1); PG8_BAR; PG8_SCHED;
            PG8_LDA(At, 1, 1); PG8_STAGE(PG8_SB(1, 0), b3, voffB); PG8_STAGE(PG8_SB(1, 1), b3 + hstepB, voffB); PG8_STAGE(PG8_SA(1, 0), a3, voffA);
            PG8_WAIT_V(8); PG8_WAIT_L(0); PG8_BAR; PG8_MMA(1, 0, At, B0); PG8_MMA(1, 1, At, B1); PG8_BAR; PG8_SCHED;
            } else {
            PG8_LDB(B0, 0, 0); PG8_SCHED; PG8_LDA(At, 0, 0); PG8_STAGE(PG8_SA(1, 1), a1 + hstepA, voffA);
            PG8_WAIT_L(8); PG8_BAR; PG8_WAIT_L(0); PG8_MMA(0, 0, At, B0); PG8_BAR; PG8_SCHED;
            PG8_LDB(B1, 0, 1); PG8_STAGE(PG8_SB(0, 0), b2, voffB);
            PG8_BAR; PG8_WAIT_L(0); PG8_MMA(0, 1, At, B1); PG8_BAR;
            PG8_LDA(At, 0, 1); PG8_STAGE(PG8_SA(0, 0), a2, voffA);
            PG8_BAR; PG8_WAIT_L(0); PG8_MMA(1, 0, At, B0); PG8_BAR; PG8_SCHED;
            PG8_STAGE(PG8_SB(0, 1), b2 + hstepB, voffB);
            PG8_WAIT_V(6); PG8_BAR; PG8_MMA(1, 1, At, B1); PG8_BAR;
            PG8_LDB(B0, 1, 0); PG8_SCHED; PG8_LDA(At, 1, 0); PG8_STAGE(PG8_SA(0, 1), a2 + hstepA, voffA);
            PG8_WAIT_L(8); PG8_BAR; PG8_WAIT_L(0); PG8_MMA(0, 0, At, B0); PG8_BAR; PG8_SCHED;
            PG8_LDB(B1, 1, 1); PG8_STAGE(PG8_SB(1, 0), b3, voffB);
            PG8_BAR; PG8_WAIT_L(0); PG8_MMA(0, 1, At, B1); PG8_BAR;
            PG8_LDA(At, 1, 1); PG8_STAGE(PG8_SA(1, 0), a3, voffA);
            PG8_BAR; PG8_WAIT_L(0); PG8_MMA(1, 0, At, B0); PG8_BAR; PG8_SCHED;
            PG8_STAGE(PG8_SB(1, 1), b3 + hstepB, voffB);
            PG8_WAIT_V(6); PG8_BAR; PG8_MMA(1, 1, At, B1); PG8_BAR;
            }
        }
        if constexpr (ALIGN_EPI) { if (wr == 0) PG8_BAR; }
        if constexpr (!Epi::AFTER_DRAIN) { E(acc, cur, wr, wc, fr, fq); S.done(cur); }
        if (!has_next) break;
#pragma unroll
        for (int a = 0; a < 2; ++a)
#pragma unroll
            for (int b = 0; b < 2; ++b)
#pragma unroll
                for (int m = 0; m < 4; ++m)
#pragma unroll
                    for (int n = 0; n < 2; ++n) acc[a][b][m][n] = pg8_zero4<acc_t>();
        cur = nxt; cA = nA; cB = nB; ++ui;
        if constexpr (ALIGN_EPI) { if (wr == 1) PG8_BAR; }
    }
    PG8_WAIT_V(0);
    if constexpr (!ALIGN_EPI) { if (wr == 0) PG8_BAR; }
    PG8_BAR;
    if constexpr (Epi::AFTER_DRAIN) { E.fused(acc, cur, wr, wc, fr, fq, lds, wid, lane); S.done(cur); }
#undef PG8_AOFF
#undef PG8_SA
#undef PG8_SB
#undef PG8_STAGE
#undef PG8_LDA
#undef PG8_LDB
#undef PG8_MMA
#undef PG8_WAIT_V
#undef PG8_WAIT_L
#undef PG8_BAR
#undef PG8_SCHED
}
}

#define GAS __attribute__((address_space(1)))
#define LAS __attribute__((address_space(3)))
typedef unsigned short bf16;
typedef unsigned v4u __attribute__((ext_vector_type(4)));
typedef float f32x4 __attribute__((ext_vector_type(4)));
typedef short bf16x8 __attribute__((ext_vector_type(8)));
typedef GAS unsigned gu32;
typedef GAS unsigned long long gu64;
#define RLX_AGENT __ATOMIC_RELAXED, __HIP_MEMORY_SCOPE_AGENT
#define LDS_WAIT() asm volatile("s_waitcnt lgkmcnt(0)" ::: "memory")
#define VM_WAIT() asm volatile("s_waitcnt vmcnt(0)" ::: "memory")
__device__ __forceinline__ unsigned long long rt() { return __builtin_amdgcn_s_memrealtime(); }
__device__ __forceinline__ unsigned f2bf(float f) { unsigned u = __builtin_bit_cast(unsigned, f); return (u + 0x7fffu + ((u >> 16) & 1u)) >> 16; }
__device__ __forceinline__ unsigned pk2(float lo, float hi) { return f2bf(lo) | (f2bf(hi) << 16); }

#define XB_TMO      128
#define XB_XCNT(j)  (256  + 64 * (j))
#define XB_XSUB(j)  (1280 + 64 * (j))
#define XB_XGEN(j)  (2304 + 64 * (j))
#define XB_TOP      3328
#define XB_TOPGEN   3392
#define XCD_BAR_WORDS 3456
#define XB_SPIN_CAP (1u << 18)

__device__ __forceinline__ unsigned xb_ld(unsigned* p)              { return __hip_atomic_load(p, __ATOMIC_RELAXED, __HIP_MEMORY_SCOPE_AGENT); }
__device__ __forceinline__ unsigned xb_add(unsigned* p, unsigned v) { return __hip_atomic_fetch_add(p, v, __ATOMIC_RELAXED, __HIP_MEMORY_SCOPE_AGENT); }
__device__ __forceinline__ unsigned xb_xcc_id() { return (unsigned)__builtin_amdgcn_s_getreg((3 << 11) | 20) & 0xFu; }
#define XB_SPIN(cond, bar) do { unsigned _sp = 0; while (cond) { __builtin_amdgcn_s_sleep(1); \
    if ((++_sp & 255u) == 0u) { if (xb_ld(&(bar)[XB_TMO])) break; if (_sp > XB_SPIN_CAP) { atomicAdd(&(bar)[XB_TMO], 1u); break; } } } } while (0)

struct XcdBarrier {
    unsigned* bar; unsigned x;
    volatile LAS unsigned* st;
};

__device__ __forceinline__ XcdBarrier xcd_barrier_post(unsigned* bar, volatile LAS unsigned* st) {
    XcdBarrier b; b.bar = bar; b.x = xb_xcc_id(); b.st = st;
    if (threadIdx.x == 0) (void)xb_add(&bar[XB_XCNT(b.x)], 1u);
    return b;
}
__device__ __forceinline__ void xcd_barrier_complete(unsigned* bar, unsigned x, unsigned& nloc, unsigned& nx) {
    const unsigned G = gridDim.x * gridDim.y * gridDim.z;
    unsigned sum, cnt, mine, sp = 0u;
    for (;;) {
        sum = 0u; cnt = 0u; mine = 0u;
#pragma unroll 1
        for (unsigned j = 0; j < 16; ++j) { const unsigned c = xb_ld(&bar[XB_XCNT(j)]); sum += c; cnt += (c > 0u) ? 1u : 0u; mine = (j == x) ? c : mine; }
        if (sum == G) break;
        __builtin_amdgcn_s_sleep(1);
        if ((++sp & 255u) == 0u) { if (xb_ld(&bar[XB_TMO])) break; if (sp > XB_SPIN_CAP) { atomicAdd(&bar[XB_TMO], 1u); break; } }
    }
    nloc = mine > 0u ? mine : 1u; nx = cnt > 0u ? cnt : 1u;
}

__device__ __forceinline__ void xcd_barrier(const XcdBarrier& b) {
    asm volatile("s_waitcnt vmcnt(0)" ::: "memory");
    __syncthreads();
    if (threadIdx.x == 0) {
        unsigned* bar = b.bar;
        __builtin_amdgcn_s_waitcnt(0);
        unsigned nloc = b.st[0], nx = b.st[1];
        if (nloc == 0u) { xcd_barrier_complete(bar, b.x, nloc, nx); b.st[0] = nloc; b.st[1] = nx; }
        const unsigned old = xb_add(&bar[XB_XSUB(b.x)], 1u);
        const unsigned gen = old / nloc;
        if (old + 1u == (gen + 1u) * nloc) {
            __builtin_amdgcn_fence(__ATOMIC_RELEASE, "agent");
            asm volatile("s_waitcnt vmcnt(0)" ::: "memory");
            const unsigned og = xb_add(&bar[XB_TOP], 1u);
            const unsigned tg = og / nx;
            if (og + 1u == (tg + 1u) * nx) xb_add(&bar[XB_TOPGEN], 1u);
            else XB_SPIN(xb_ld(&bar[XB_TOPGEN]) == tg, bar);
            __builtin_amdgcn_fence(__ATOMIC_ACQUIRE, "agent");
            xb_add(&bar[XB_XGEN(b.x)], 1u);
            asm volatile("s_waitcnt vmcnt(0)" ::: "memory");
        } else {
            XB_SPIN(xb_ld(&bar[XB_XGEN(b.x)]) == gen, bar);
            __builtin_amdgcn_fence(__ATOMIC_ACQUIRE, "agent");
            asm volatile("s_waitcnt vmcnt(0)" ::: "memory");
        }
    }
    __syncthreads();
}

constexpr int NWAVES = 8;
constexpr int NB = 16, SEQ = 2048, DM = 1024, MTOK = NB * SEQ, DEPTH = 4;
constexpr int P_IN = 2988, NPROJ = 3072, DFF = 2816, NUP = 2 * DFF, CHROWS = MTOK / 2;
constexpr float RMS_EPS = 1e-6f;
#ifndef MK_N_LAUNCHES
#define MK_N_LAUNCHES 1
#endif
#ifndef PROBE_MASK
#define PROBE_MASK 0
#endif
constexpr int NP = 11;
constexpr int NPH = DEPTH * NP + 1;

constexpr size_t MiB = 1u << 20;
constexpr size_t WS_CTL = 0, CTL_ZERO_BYTES = 1 * MiB;
constexpr size_t WS_WIN = 1 * MiB, WS_WG = 7 * MiB, WS_WB = 15 * MiB, WS_WO = 17 * MiB, WS_WUP = 19 * MiB, WS_WD = 30 * MiB;
constexpr size_t WS_MASK = 36 * MiB;
constexpr size_t WS_CUM = 44 * MiB;
constexpr size_t WS_KMEAN = 45 * MiB;
constexpr size_t WS_SSA = 46 * MiB, WS_SSB = 47 * MiB;
constexpr size_t WS_WALT = 47 * MiB;
constexpr size_t WS_PQ = 112 * MiB, WS_PK = 176 * MiB, WS_PV = 240 * MiB;
constexpr size_t WS_MIX = 112 * MiB;
constexpr size_t WS_XB = 432 * MiB;
constexpr size_t WS_BV = 176 * MiB;
constexpr size_t WS_HALO = 112 * MiB;
constexpr size_t WS_ACT = 144 * MiB;
constexpr size_t WS_PARTA = 496 * MiB, WS_PARTB = 498 * MiB;
constexpr size_t WS_X8 = 320 * MiB;
constexpr size_t WS_X18 = 352 * MiB;
constexpr size_t WS_SX = 384 * MiB, WS_SX1 = 385 * MiB;
constexpr size_t WS_WIN8 = 401 * MiB;
constexpr size_t WS_SWIN = 405 * MiB;
constexpr size_t WS_CMAXI = 256 * 1024;
constexpr size_t WS_SSA1 = 399 * MiB, WS_SSB1 = 400 * MiB;
constexpr size_t WS_WG8 = 386 * MiB;
constexpr size_t WS_WUP8 = 392 * MiB;
constexpr size_t WS_CMAXU = 128 * 1024;
constexpr size_t WS_END = 500 * MiB;
static_assert(WS_BV + (size_t)MTOK * 4096 * 2 <= WS_XB && WS_HALO + (size_t)(MTOK / 64) * 4 * NUP * 2 <= WS_ACT && WS_ACT + (size_t)MTOK * DFF * 2 <= WS_XB && WS_XB + (size_t)MTOK * 1024 * 2 <= WS_END, "ws map");
constexpr int CW_TMO = 0, CW_CODE = 1, CW_BAR = 4096, CW_WMAXG = 16384, CW_WMAXU = 16400;

constexpr int RING_OFF = 0, RING_BYTES = 131072;
constexpr int AUX_OFF = 131072;
constexpr int AUXW_OFF = AUX_OFF + 16384;
constexpr int LUT_OFF = AUXW_OFF + 512, LUT_STRIDE = 132;
constexpr int LUT2_OFF = LUT_OFF + 8 * LUT_STRIDE * 4;
constexpr int LDSCTL_OFF = LUT2_OFF + 8 * LUT_STRIDE * 4, MISC_OFF = LDSCTL_OFF + 64;
constexpr int LDS_BYTES = 159744;
static_assert(MISC_OFF + 128 <= LDS_BYTES, "LDS map");

struct Args { const float* in[14]; float* out; unsigned char* ws; int g_lo, g_hi, li, pad; };
struct Frame {
    LAS unsigned char* lds;
    volatile LAS unsigned* MISC;
    unsigned char* ws;
    int tid, lane, wave;
    int vcu, G;
};
typedef __attribute__((address_space(4))) const Args CArgs;
__device__ __forceinline__ const float* inp(int i) { CArgs* p = (CArgs*)__builtin_amdgcn_kernarg_segment_ptr(); asm volatile("" : "+s"(p)); return p->in[i]; }
__device__ __forceinline__ float* outp() { CArgs* p = (CArgs*)__builtin_amdgcn_kernarg_segment_ptr(); asm volatile("" : "+s"(p)); return p->out; }
#define F_CTL ((gu32*)(F.ws + WS_CTL))
#define F_WinT ((bf16*)(F.ws + WS_WIN + wofs))
#define F_WgT ((bf16*)(F.ws + WS_WG + wofs))
#define F_WbT ((bf16*)(F.ws + WS_WB + wofs))
#define F_WoT ((bf16*)(F.ws + WS_WO + wofs))
#define F_WupT ((bf16*)(F.ws + WS_WUP + wofs))
#define F_WdT ((bf16*)(F.ws + WS_WD + wofs))
#define F_PQ ((bf16*)(F.ws + WS_PQ))
#define F_PK ((bf16*)(F.ws + WS_PK))
#define F_PV ((bf16*)(F.ws + WS_PV))
#define F_MIX ((bf16*)(F.ws + WS_MIX))
#define F_XB ((bf16*)(F.ws + WS_XB))
#define F_BV ((bf16*)(F.ws + WS_BV))
#define F_BVQ ((unsigned char*)(F.ws + WS_BV))
#define F_X8 ((unsigned char*)(F.ws + WS_X8))
#define F_X18 ((unsigned char*)(F.ws + WS_X18))
#define F_SX ((float*)(F.ws + WS_SX))
#define F_SX1 ((float*)(F.ws + WS_SX1))
#define F_SSA1 ((float*)(F.ws + WS_SSA1))
#define F_SSB1 ((float*)(F.ws + WS_SSB1))
#define F_WG8 ((unsigned char*)(F.ws + WS_WG8))
#define F_WUP8 ((unsigned char*)(F.ws + WS_WUP8))
#define F_CMAXU ((float*)(F.ws + WS_CMAXU))
#define F_CMAXI ((float*)(F.ws + WS_CMAXI))
#define F_WIN8 ((unsigned char*)(F.ws + WS_WIN8))
#define F_SWIN ((float*)(F.ws + WS_SWIN))
#define F_HALO ((bf16*)(F.ws + WS_HALO))
#define F_ACT ((bf16*)(F.ws + WS_ACT))
#define F_MASK ((unsigned long long*)(F.ws + WS_MASK))
#define F_CUM ((float*)(F.ws + WS_CUM))
#define F_KMEAN ((float*)(F.ws + WS_KMEAN))
#define F_SSA ((float*)(F.ws + WS_SSA))
#define F_SSB ((float*)(F.ws + WS_SSB))
#define F_PARTA ((float*)(F.ws + WS_PARTA))
#define F_PARTB ((float*)(F.ws + WS_PARTB))
__device__ __forceinline__ float shx(float v, int lane, int mask) { return __builtin_bit_cast(float, __builtin_amdgcn_ds_bpermute((lane ^ mask) << 2, __builtin_bit_cast(int, v))); }
__device__ __forceinline__ float wave_sum(float v, int lane) {
#pragma unroll
    for (int o = 1; o < 64; o <<= 1) v += shx(v, lane, o);
    return v;
}
__device__ __forceinline__ float bf2f(unsigned short b) { return __uint_as_float((unsigned)b << 16); }
__device__ __forceinline__ float bflo(unsigned w) { return __uint_as_float(w << 16); }
__device__ __forceinline__ float bfhi(unsigned w) { return __uint_as_float(w & 0xffff0000u); }
template <class T> __device__ __forceinline__ T* vptr(T* p) { asm volatile("" : "+v"(p)); return p; }

__device__ __forceinline__ long proj_src_col(int n) {
    const int t = n >> 10, c = n & 1023;
    if (t == 0) { const int s = c >> 8, r = c & 255; return (s == 0 ? 0 : s == 1 ? 768 : s == 2 ? 1536 : 2308) + r; }
    if (t == 2) { const int s = c >> 8, r = c & 255; return (s == 0 ? 512 : s == 1 ? 1280 : s == 2 ? 2048 : 2692) + r; }
    if (c < 768) { const int s = c >> 8, r = c & 255; return (s == 0 ? 256 : s == 1 ? 1024 : 1792) + r; }
    if (c < 832) return 2564 + (c - 768);
    if (c < 896) return 2628 + (c - 832);
    if (c < 928) return 2948 + (c - 896);
    if (c < 936) return 2980 + (c - 928);
    if (c < 940) return 2304 + (c - 936);
    return -1;
}
struct MapProj { __device__ __forceinline__ long operator()(int n) const { return proj_src_col(n); } };
struct MapId { __device__ __forceinline__ long operator()(int n) const { return n; } };
struct MapGate { __device__ __forceinline__ long operator()(int R) const { const int pn = R >> 8, c = R & 255, bj = c >> 7, wc = (c >> 5) & 3, nn = (c >> 4) & 1, fq = (c >> 2) & 3, e = c & 3;
    return (long)(2 * bj + nn) * (1024L * 1024L) + 64 * pn + 16 * wc + 4 * fq + e; } };
struct MapUp { __device__ __forceinline__ long operator()(int R) const { const int pn = R >> 8, c = R & 255; return (long)(c >> 7) * DFF + 128 * pn + (c & 127); } };
struct MapBranch { __device__ __forceinline__ long operator()(int R) const { return (long)(R >> 10) * (256L * 1024L) + (R & 1023); } };
template <class Map> __device__ __forceinline__ void tr_item(const float* W, int K, int Nsrc, bf16* WT, const Map& map, LAS float* scr, int item, int nblk, int lane, const float* gk = nullptr) {
    const int kb = item / nblk, nb = item % nblk, k0 = 64 * kb, n0 = 32 * nb;
    const int kr = lane >> 3, q = lane & 7; const long so = map(n0 + 4 * q);
    f32x4 ld[8];
#pragma unroll
    for (int i = 0; i < 8; ++i) { ld[i] = so >= 0 ? *(const GAS f32x4*)(W + (size_t)so + (size_t)(k0 + kr + 8 * i) * Nsrc) : (f32x4){0.f, 0.f, 0.f, 0.f}; if (gk) ld[i] = ld[i] * gk[k0 + kr + 8 * i]; }
#pragma unroll
    for (int i = 0; i < 8; ++i) { LAS float* d = scr + (kr + 8 * i) * 33 + 4 * q; d[0] = ld[i].x; d[1] = ld[i].y; d[2] = ld[i].z; d[3] = ld[i].w; }
    LDS_WAIT(); asm volatile("" ::: "memory");
    const int c = lane & 7;
#pragma unroll
    for (int j = 0; j < 4; ++j) { const int n = (lane >> 3) + 8 * j; const LAS float* s = scr + (8 * c) * 33 + n;
        v4u o; o.x = pk2(s[0 * 33], s[1 * 33]); o.y = pk2(s[2 * 33], s[3 * 33]); o.z = pk2(s[4 * 33], s[5 * 33]); o.w = pk2(s[6 * 33], s[7 * 33]);
        *(GAS v4u*)(WT + (size_t)(n0 + n) * K + k0 + 8 * c) = o; }
    LDS_WAIT(); asm volatile("" ::: "memory");
}
__device__ __forceinline__ float wave_max(float v, int lane) {
#pragma unroll
    for (int o = 1; o < 64; o <<= 1) v = fmaxf(v, shx(v, lane, o));
    return v;
}
__device__ __forceinline__ unsigned q8x4(float a, float b, float c, float d, float inv) {
    const unsigned b0 = __float_as_uint(fmaf(a, inv, 12582912.0f)), b1 = __float_as_uint(fmaf(b, inv, 12582912.0f)), b2 = __float_as_uint(fmaf(c, inv, 12582912.0f)), b3 = __float_as_uint(fmaf(d, inv, 12582912.0f));
    return __builtin_amdgcn_perm(b1, b0, 0x0c0c0400u) | __builtin_amdgcn_perm(b3, b2, 0x04000c0cu);
}
__device__ __forceinline__ void init_row(const f32x4 (&xa)[2], const f32x4 (&xb_)[2], bf16* xb_dst, float* ssrow, unsigned char* q8row, float* sxrow, float* ss1row, int lane) {
    typedef unsigned u32x2 __attribute__((ext_vector_type(2)));
    float s = 0.f, am = 1.0e-30f; f32x4 va[2], vb[2];
#pragma unroll
    for (int j = 0; j < 2; ++j) { const int c = lane + 64 * j; const f32x4 a = xa[j], b = xb_[j];
        v4u xo; xo.x = pk2(a.x, a.y); xo.y = pk2(a.z, a.w); xo.z = pk2(b.x, b.y); xo.w = pk2(b.z, b.w); ((GAS v4u*)xb_dst)[c] = xo;
        const f32x4 ar = (f32x4){bflo(xo.x), bfhi(xo.x), bflo(xo.y), bfhi(xo.y)}, br = (f32x4){bflo(xo.z), bfhi(xo.z), bflo(xo.w), bfhi(xo.w)}; va[j] = ar; vb[j] = br;
        s += ((a.x * a.x + a.y * a.y) + (a.z * a.z + a.w * a.w)) + ((b.x * b.x + b.y * b.y) + (b.z * b.z + b.w * b.w));
        am = fmaxf(am, fmaxf(fmaxf(fabsf(ar.x), fabsf(ar.y)), fmaxf(fabsf(ar.z), fabsf(ar.w)))); am = fmaxf(am, fmaxf(fmaxf(fabsf(br.x), fabsf(br.y)), fmaxf(fabsf(br.z), fabsf(br.w)))); }
    s = wave_sum(s, lane); am = wave_max(am, lane);
    const float inv = 127.0f * __builtin_amdgcn_rcpf(am);
#pragma unroll
    for (int j = 0; j < 2; ++j) { u32x2 o; o.x = q8x4(va[j].x, va[j].y, va[j].z, va[j].w, inv); o.y = q8x4(vb[j].x, vb[j].y, vb[j].z, vb[j].w, inv); ((GAS u32x2*)q8row)[lane + 64 * j] = o; }
    if (lane == 0) { *(GAS f32x4*)ssrow = (f32x4){s, 0.f, 0.f, 0.f}; *(GAS float*)ss1row = s; *(GAS float*)sxrow = am * (1.0f / 127.0f); }
}
__device__ __forceinline__ float wmax_rows(const float* W, const float* gain, int r0, int nrows, int ncol, int lane) {
    float m = 0.f;
    for (int r = r0; r < r0 + nrows; ++r) { const float g = fabsf(gain[r & 1023]); const GAS f32x4* rp = (const GAS f32x4*)(W + (size_t)r * ncol); float mr = 0.f;
        for (int c = lane; c < ncol / 4; c += 64) { const f32x4 v = rp[c]; mr = fmaxf(fmaxf(mr, fabsf(v.x)), fmaxf(fabsf(v.y), fmaxf(fabsf(v.z), fabsf(v.w)))); }
        m = fmaxf(m, mr * g); }
    return wave_max(m, lane);
}
__device__ __forceinline__ void p_wmax(Frame& F) {
    const int gw = F.vcu * NWAVES + F.wave, NGW = F.G * NWAVES, lane = F.lane;
    for (int it = gw; it < DEPTH * 512; it += NGW) { const int l = it >> 9; const float m = wmax_rows(inp(7) + (size_t)l * 4 * DM * DM, inp(1) + l * DM, (it & 511) * 8, 8, DM, lane);
        if (lane == 0) __hip_atomic_fetch_max((unsigned*)(F_CTL + CW_WMAXG + l), __float_as_uint(m), __ATOMIC_RELAXED, __HIP_MEMORY_SCOPE_AGENT); }
    for (int it = gw; it < DEPTH * 47 * 4; it += NGW) { const int l = it / (47 * 4), rem = it % (47 * 4), strip = rem >> 2, kq = rem & 3; const int c0 = strip * 64 + 4 * (lane & 15);
        if (c0 < P_IN) {
            const float* W = inp(4) + (size_t)l * DM * P_IN + c0; const GAS float* gain = (const GAS float*)(inp(1) + l * DM);
            f32x4 m = (f32x4){0.f, 0.f, 0.f, 0.f};
#pragma unroll 8
            for (int k = kq * 256 + (lane >> 4); k < kq * 256 + 256; k += 4) { const f32x4 v = *(const GAS f32x4*)(W + (size_t)k * P_IN); const float g = fabsf(gain[k]);
                m.x = fmaxf(m.x, fabsf(v.x) * g); m.y = fmaxf(m.y, fabsf(v.y) * g); m.z = fmaxf(m.z, fabsf(v.z) * g); m.w = fmaxf(m.w, fabsf(v.w) * g); }
            m.x = fmaxf(m.x, shx(m.x, lane, 16)); m.y = fmaxf(m.y, shx(m.y, lane, 16)); m.z = fmaxf(m.z, shx(m.z, lane, 16)); m.w = fmaxf(m.w, shx(m.w, lane, 16));
            m.x = fmaxf(m.x, shx(m.x, lane, 32)); m.y = fmaxf(m.y, shx(m.y, lane, 32)); m.z = fmaxf(m.z, shx(m.z, lane, 32)); m.w = fmaxf(m.w, shx(m.w, lane, 32));
            unsigned* cp = (unsigned*)(F_CMAXI + (size_t)l * 3008 + c0);
            if (lane < 16) { __hip_atomic_fetch_max(cp, __float_as_uint(m.x), __ATOMIC_RELAXED, __HIP_MEMORY_SCOPE_AGENT); __hip_atomic_fetch_max(cp + 1, __float_as_uint(m.y), __ATOMIC_RELAXED, __HIP_MEMORY_SCOPE_AGENT);
            __hip_atomic_fetch_max(cp + 2, __float_as_uint(m.z), __ATOMIC_RELAXED, __HIP_MEMORY_SCOPE_AGENT); __hip_atomic_fetch_max(cp + 3, __float_as_uint(m.w), __ATOMIC_RELAXED, __HIP_MEMORY_SCOPE_AGENT); } } }
    for (int it = gw; it < DEPTH * (NUP / 64) * 4; it += NGW) { const int l = it / ((NUP / 64) * 4), rem = it % ((NUP / 64) * 4), strip = rem >> 2, kq = rem & 3;
        const float* W = inp(10) + (size_t)l * DM * NUP + strip * 64 + 4 * (lane & 15); const GAS float* gain = (const GAS float*)(inp(2) + l * DM);
        f32x4 m = (f32x4){0.f, 0.f, 0.f, 0.f};
#pragma unroll 8
        for (int k = kq * 256 + (lane >> 4); k < kq * 256 + 256; k += 4) { const f32x4 v = *(const GAS f32x4*)(W + (size_t)k * NUP); const float g = fabsf(gain[k]);
            m.x = fmaxf(m.x, fabsf(v.x) * g); m.y = fmaxf(m.y, fabsf(v.y) * g); m.z = fmaxf(m.z, fabsf(v.z) * g); m.w = fmaxf(m.w, fabsf(v.w) * g); }
        m.x = fmaxf(m.x, shx(m.x, lane, 16)); m.y = fmaxf(m.y, shx(m.y, lane, 16)); m.z = fmaxf(m.z, shx(m.z, lane, 16)); m.w = fmaxf(m.w, shx(m.w, lane, 16));
        m.x = fmaxf(m.x, shx(m.x, lane, 32)); m.y = fmaxf(m.y, shx(m.y, lane, 32)); m.z = fmaxf(m.z, shx(m.z, lane, 32)); m.w = fmaxf(m.w, shx(m.w, lane, 32));
        if (lane < 16) { unsigned* cp = (unsigned*)(F_CMAXU + (size_t)l * NUP + strip * 64 + 4 * lane);
            __hip_atomic_fetch_max(cp, __float_as_uint(m.x), __ATOMIC_RELAXED, __HIP_MEMORY_SCOPE_AGENT); __hip_atomic_fetch_max(cp + 1, __float_as_uint(m.y), __ATOMIC_RELAXED, __HIP_MEMORY_SCOPE_AGENT);
            __hip_atomic_fetch_max(cp + 2, __float_as_uint(m.z), __ATOMIC_RELAXED, __HIP_MEMORY_SCOPE_AGENT); __hip_atomic_fetch_max(cp + 3, __float_as_uint(m.w), __ATOMIC_RELAXED, __HIP_MEMORY_SCOPE_AGENT); } }
}
template <class Map> __device__ __forceinline__ void tr_item8(const float* W, int K, int Nsrc, unsigned char* WT8, const Map& map, LAS float* scr, int item, int nblk, int lane, const float* gk, float inv, const float* cmax = nullptr, float* swout = nullptr) {
    typedef unsigned u32x2 __attribute__((ext_vector_type(2)));
    const int kb = item / nblk, nb = item % nblk, k0 = 64 * kb, n0 = 32 * nb;
    const int kr = lane >> 3, q = lane & 7; const long so = map(n0 + 4 * q);
    f32x4 ld[8]; f32x4 inv4 = (f32x4){inv, inv, inv, inv};
    if (cmax) { const f32x4 c4 = so >= 0 ? *(const GAS f32x4*)(cmax + so) : (f32x4){0.f, 0.f, 0.f, 0.f};
        if (swout && kb == 0 && kr == 0) *(GAS f32x4*)(swout + n0 + 4 * q) = c4 * (1.0f / 127.0f);
        inv4 = (f32x4){127.0f / fmaxf(c4.x, 1.0e-30f), 127.0f / fmaxf(c4.y, 1.0e-30f), 127.0f / fmaxf(c4.z, 1.0e-30f), 127.0f / fmaxf(c4.w, 1.0e-30f)}; }
#pragma unroll
    for (int i = 0; i < 8; ++i) { ld[i] = so >= 0 ? *(const GAS f32x4*)(W + (size_t)so + (size_t)(k0 + kr + 8 * i) * Nsrc) : (f32x4){0.f, 0.f, 0.f, 0.f}; ld[i] = ld[i] * gk[k0 + kr + 8 * i] * inv4; }
#pragma unroll
    for (int i = 0; i < 8; ++i) { LAS float* d = scr + (kr + 8 * i) * 33 + 4 * q; d[0] = ld[i].x; d[1] = ld[i].y; d[2] = ld[i].z; d[3] = ld[i].w; }
    LDS_WAIT(); asm volatile("" ::: "memory");
    const int c = lane & 7;
#pragma unroll
    for (int j = 0; j < 4; ++j) { const int n = (lane >> 3) + 8 * j; const LAS float* s = scr + (8 * c) * 33 + n;
        u32x2 o; o.x = q8x4(s[0 * 33], s[1 * 33], s[2 * 33], s[3 * 33], 1.0f); o.y = q8x4(s[4 * 33], s[5 * 33], s[6 * 33], s[7 * 33], 1.0f);
        *(GAS u32x2*)(WT8 + (size_t)(n0 + n) * K + k0 + 8 * c) = o; }
    LDS_WAIT(); asm volatile("" ::: "memory");
}
template <int NR> __device__ __forceinline__ void quant_rows(const bf16* xb, unsigned char* q8, float* sxv, const float* ss4, float* ss1, int m0, int mstride, int lane) {
    typedef unsigned u32x2 __attribute__((ext_vector_type(2)));
    v4u t[NR][2];
#pragma unroll
    for (int r = 0; r < NR; ++r)
#pragma unroll
        for (int j = 0; j < 2; ++j) t[r][j] = ((const GAS v4u*)(xb + (size_t)min(m0 + r * mstride, MTOK - 1) * DM))[lane + 64 * j];
#pragma unroll
    for (int r = 0; r < NR; ++r) { const int m = m0 + r * mstride; if (m >= MTOK) break;
        float v[16]; float am = 1.0e-30f;
#pragma unroll
        for (int j = 0; j < 2; ++j) { const v4u tt = t[r][j];
            v[8 * j] = bflo(tt.x); v[8 * j + 1] = bfhi(tt.x); v[8 * j + 2] = bflo(tt.y); v[8 * j + 3] = bfhi(tt.y); v[8 * j + 4] = bflo(tt.z); v[8 * j + 5] = bfhi(tt.z); v[8 * j + 6] = bflo(tt.w); v[8 * j + 7] = bfhi(tt.w); }
#pragma unroll
        for (int j = 0; j < 16; ++j) am = fmaxf(am, fabsf(v[j]));
        am = wave_max(am, lane);
        const float inv = 127.0f * __builtin_amdgcn_rcpf(am);
#pragma unroll
        for (int j = 0; j < 2; ++j) { u32x2 o; o.x = q8x4(v[8 * j], v[8 * j + 1], v[8 * j + 2], v[8 * j + 3], inv); o.y = q8x4(v[8 * j + 4], v[8 * j + 5], v[8 * j + 6], v[8 * j + 7], inv);
            ((GAS u32x2*)(q8 + (size_t)m * DM))[lane + 64 * j] = o; }
        if (lane == 0) { *(GAS float*)(sxv + m) = am * (1.0f / 127.0f); const f32x4 p4 = *(const GAS f32x4*)(ss4 + 4 * (size_t)m); *(GAS float*)(ss1 + m) = (p4.x + p4.y) + (p4.z + p4.w); } }
}
__device__ __forceinline__ void p_quant(Frame& F, int l) {
    LAS float* scr = (LAS float*)(F.lds + RING_OFF + F.wave * 16384);
    const int gw = F.vcu * NWAVES + F.wave, NGW = F.G * NWAVES;
    {   const float wm = fmaxf(__uint_as_float(*vptr((const GAS unsigned*)(F_CTL + CW_WMAXG + l))), 1.0e-30f); const float inv = 127.0f / wm;
        const float* w_gate = inp(7) + (size_t)l * 4 * DM * DM; const float* gmix = inp(1) + l * DM;
        for (int it = gw; it < 16 * 128; it += NGW) tr_item8(w_gate, DM, DM, F_WG8, MapGate(), scr, it, 128, F.lane, gmix, inv); }
    {   const float* w_up = inp(10) + (size_t)l * DM * NUP; const float* gffn = inp(2) + l * DM;
        for (int it = gw; it < 16 * 176; it += NGW) tr_item8(w_up, DM, NUP, F_WUP8, MapUp(), scr, it, 176, F.lane, gffn, 1.0f, F_CMAXU + (size_t)l * NUP); }
}
__device__ __forceinline__ void p_quant0(Frame& F) {
    const int gw = F.vcu * NWAVES + F.wave, NGW = F.G * NWAVES;
    for (int m = gw; m < MTOK; m += 16 * NGW) quant_rows<16>(F_XB, F_X8, F_SX, F_SSA, F_SSA1, m, NGW, F.lane);
}
__device__ __forceinline__ void p_quant1(Frame& F) {
    const int gw = F.vcu * NWAVES + F.wave, NGW = F.G * NWAVES;
    for (int m = gw; m < MTOK; m += 16 * NGW) quant_rows<16>(F_XB, F_X18, F_SX1, F_SSB, F_SSB1, m, NGW, F.lane);
}
__device__ __forceinline__ void p_wconv(Frame& F, int l, const size_t wofs) {
    LAS float* scr = (LAS float*)(F.lds + RING_OFF + F.wave * 16384);
    const int gw = F.vcu * NWAVES + F.wave, NGW = F.G * NWAVES;
    constexpr int I_WIN = 16 * 96, I_WG = 0  , I_WB = 4 * 128, I_WO = 16 * 32, I_WUP = 0  , I_WD = 44 * 32;
    constexpr int NITEMS = I_WIN + I_WG + I_WB + I_WO + I_WUP + I_WD;
    const float* w_in = inp(4) + (size_t)l * DM * P_IN; const float* w_gate = inp(7) + (size_t)l * 4 * DM * DM; const float* w_branch = inp(8) + (size_t)l * 4 * 256 * DM;
    const float* w_out = inp(9) + (size_t)l * DM * DM; const float* w_up = inp(10) + (size_t)l * DM * NUP; const float* w_down = inp(13) + (size_t)l * DFF * DM;
    const float* gmix = inp(1) + l * DM; const float* gffn = inp(2) + l * DM;
    for (int it = gw; it < NITEMS; it += NGW) {
        int r = it;
        if (r < I_WIN) { tr_item8(w_in, DM, P_IN, F_WIN8, MapProj(), scr, r, 96, F.lane, gmix, 1.0f, F_CMAXI + (size_t)l * 3008, F_SWIN); continue; } r -= I_WIN;
        if (r < I_WG) { tr_item(w_gate, DM, DM, F_WgT, MapGate(), scr, r, 128, F.lane, gmix); continue; } r -= I_WG;
        if (r < I_WB) { tr_item(w_branch, 256, DM, F_WbT, MapBranch(), scr, r, 128, F.lane); continue; } r -= I_WB;
        if (r < I_WO) { tr_item(w_out, DM, DM, F_WoT, MapId(), scr, r, 32, F.lane); continue; } r -= I_WO;
        if (r < I_WUP) { tr_item(w_up, DM, NUP, F_WupT, MapUp(), scr, r, 176, F.lane, gffn); continue; } r -= I_WUP;
        tr_item(w_down, DFF, DM, F_WdT, MapId(), scr, r, 32, F.lane);
    }
}
__device__ __forceinline__ void p_init(Frame& F) {
    const int gw = F.vcu * NWAVES + F.wave, NGW = F.G * NWAVES; const float* x = inp(0);
    for (int m0 = gw; m0 < MTOK; m0 += 4 * NGW) {
        f32x4 xa[4][2], xb_[4][2];
#pragma unroll
        for (int r = 0; r < 4; ++r)
#pragma unroll
            for (int j = 0; j < 2; ++j) { const GAS f32x4* xr = (const GAS f32x4*)(x + (size_t)min(m0 + r * NGW, MTOK - 1) * DM) + 2 * (F.lane + 64 * j); xa[r][j] = xr[0]; xb_[r][j] = xr[1]; }
#pragma unroll
        for (int r = 0; r < 4; ++r) { const int m = m0 + r * NGW; if (m >= MTOK) break;
            init_row(xa[r], xb_[r], F_XB + (size_t)m * DM, F_SSA + 4 * (size_t)m, F_X8 + (size_t)m * DM, F_SX + m, F_SSA1 + m, F.lane); } }
}
__device__ __forceinline__ void zero_u64(Frame& F, unsigned long long* p, int n) {
    const int gt = (F.vcu * NWAVES + F.wave) * 64 + F.lane, NT = F.G * NWAVES * 64; unsigned z = 0u; asm volatile("" : "+v"(z));
    for (int i = gt; i < n / 2; i += NT) ((GAS v4u*)p)[i] = (v4u){z, z, z, z};
}
__device__ __forceinline__ void p_final(Frame& F, float* out, const float* gain) {
    const int gw = F.vcu * NWAVES + F.wave, NGW = F.G * NWAVES, lane = F.lane;
    f32x4 ga[2], gb[2];
#pragma unroll
    for (int j = 0; j < 2; ++j) { const GAS f32x4* gr = (const GAS f32x4*)gain + 2 * (lane + 64 * j); ga[j] = gr[0]; gb[j] = gr[1]; }
    for (int m0 = gw; m0 < MTOK; m0 += 4 * NGW) {
        v4u t[4][2];
#pragma unroll
        for (int r = 0; r < 4; ++r)
#pragma unroll
            for (int j = 0; j < 2; ++j) t[r][j] = ((const GAS v4u*)(F_XB + (size_t)min(m0 + r * NGW, MTOK - 1) * DM))[lane + 64 * j];
#pragma unroll
        for (int r = 0; r < 4; ++r) { const int m = m0 + r * NGW; if (m >= MTOK) break;
            float v[16]; float s = 0.f;
#pragma unroll
            for (int j = 0; j < 2; ++j) { const v4u tt = t[r][j];
                v[8 * j] = bflo(tt.x); v[8 * j + 1] = bfhi(tt.x); v[8 * j + 2] = bflo(tt.y); v[8 * j + 3] = bfhi(tt.y); v[8 * j + 4] = bflo(tt.z); v[8 * j + 5] = bfhi(tt.z); v[8 * j + 6] = bflo(tt.w); v[8 * j + 7] = bfhi(tt.w); }
#pragma unroll
            for (int j = 0; j < 16; ++j) s += v[j] * v[j];
            const float rstd = 1.0f / sqrtf(wave_sum(s, lane) * (1.f / DM) + RMS_EPS);
#pragma unroll
            for (int j = 0; j < 2; ++j) { GAS f32x4* op = (GAS f32x4*)(out + (size_t)m * DM) + 2 * (lane + 64 * j);
                op[0] = (f32x4){v[8 * j] * rstd * ga[j].x, v[8 * j + 1] * rstd * ga[j].y, v[8 * j + 2] * rstd * ga[j].z, v[8 * j + 3] * rstd * ga[j].w};
                op[1] = (f32x4){v[8 * j + 4] * rstd * gb[j].x, v[8 * j + 5] * rstd * gb[j].y, v[8 * j + 6] * rstd * gb[j].z, v[8 * j + 7] * rstd * gb[j].w}; } }
    }
}


namespace att {
typedef float f32x16 __attribute__((ext_vector_type(16)));
typedef short s16x4 __attribute__((ext_vector_type(4)));
typedef short bf16x8 __attribute__((ext_vector_type(8)));
typedef float f32x2_t __attribute__((ext_vector_type(2)));
typedef __bf16 bf16x2_t __attribute__((ext_vector_type(2)));
typedef unsigned u32x4_t __attribute__((ext_vector_type(4)));
__device__ __forceinline__ int crow(int r, int hi) { return (r & 3) + 8 * (r >> 2) + 4 * hi; }
constexpr int KS = 144, TILE_B = 64 * KS;
constexpr int L_K = 0, L_V = 2 * TILE_B, L_C = 4 * TILE_B, L_FLAG = L_C + 512;
constexpr float SB_DONE = -160.0f;
constexpr float FOX_SKIP = -300.0f;
constexpr float LOG2E = 1.4426950408889634f, SC2 = 0.125f * LOG2E;
__device__ __forceinline__ unsigned cvtpk(float lo, float hi) { f32x2_t v = {lo, hi}; bf16x2_t b = __builtin_convertvector(v, bf16x2_t); return __builtin_bit_cast(unsigned, b); }
__device__ __forceinline__ float xhalf_sum(float x) { auto rr = __builtin_amdgcn_permlane32_swap(__float_as_uint(x), __float_as_uint(x), false, false); return __uint_as_float(rr[0]) + __uint_as_float(rr[1]); }
__device__ __forceinline__ float xhalf_max(float x) { auto rr = __builtin_amdgcn_permlane32_swap(__float_as_uint(x), __float_as_uint(x), false, false); return fmaxf(__uint_as_float(rr[0]), __uint_as_float(rr[1])); }
__device__ __forceinline__ bf16x8 pack8(const f32x16& p, int s) {
    u32x4_t w; w.x = cvtpk(p[8 * s + 0], p[8 * s + 1]); w.y = cvtpk(p[8 * s + 2], p[8 * s + 3]); w.z = cvtpk(p[8 * s + 4], p[8 * s + 5]); w.w = cvtpk(p[8 * s + 6], p[8 * s + 7]);
    return __builtin_bit_cast(bf16x8, w);
}
__device__ __forceinline__ s16x4 vtr(const LAS unsigned char* p) { typedef short v4i16_t __attribute__((ext_vector_type(4))); return __builtin_bit_cast(s16x4, __builtin_amdgcn_ds_read_tr16_b64_v4i16((LAS v4i16_t*)p)); }

template <int MODE>
__device__ __forceinline__ void unit(Frame& F, int b, int head, int q0w, int nt, const bf16* Kg, const bf16* Vg, int qcol, bf16* Obase) {
    int tid_ = F.tid; asm volatile("" : "+v"(tid_));
    const int tid = tid_, lane = tid_ & 63, r32 = lane & 31, hi = lane >> 5;
    LAS unsigned char* L = F.lds + RING_OFF;
    const int tq = q0w + r32; const size_t rowq = (size_t)b * SEQ + tq;
    bf16x8 qf[4];
    {   const GAS bf16x8* qp = (const GAS bf16x8*)(F_PQ + rowq * 1024 + qcol + 8 * hi);
#pragma unroll
        for (int d0 = 0; d0 < 4; ++d0) qf[d0] = qp[2 * d0]; }
    const int tw = (q0w + 31) >> 6;
    const int srow = tid >> 3, spc = tid & 7;
    const GAS v4u* kg = (const GAS v4u*)(Kg + (size_t)srow * 1024 + spc * 8);
    const GAS v4u* vg = (const GAS v4u*)(Vg + (size_t)srow * 1024 + spc * 8);
    const int sdst = srow * KS + spc * 16;
    const GAS float* cg = (const GAS float*)F_CUM + (size_t)(b * 4 + head) * SEQ;
    const GAS unsigned long long* mrow = (const GAS unsigned long long*)F_MASK + rowq * 32;
    const LAS float* lut2 = (const LAS float*)(F.lds + LUT2_OFF) + ((MODE == 3 ? 4 : 0) + head) * LUT_STRIDE;
    f32x16 o0, o1;
#pragma unroll
    for (int r = 0; r < 16; ++r) { o0[r] = 0.f; o1[r] = 0.f; }
    float m = -1e30f, lsum = 0.f, carry = 0.f;
    float NINF = -INFINITY; asm volatile("" : "+v"(NINF));
    const int own = q0w >> 8; unsigned selbits = 0u;
    if (MODE == 1) {
        float gt[7];
#pragma unroll
        for (int n = 0; n < 7; ++n) { gt[n] = 0.f;
            if (n < own) { const GAS f32x4* kmp = vptr((const GAS f32x4*)((const GAS float*)F_KMEAN + ((size_t)((b * 4 + head) * 8 + n)) * 64)) + 2 * hi; float g = 0.f;
#pragma unroll
                for (int d0 = 0; d0 < 4; ++d0) { const f32x4 ka = kmp[4 * d0], kb = kmp[4 * d0 + 1]; const u32x4_t qw = __builtin_bit_cast(u32x4_t, qf[d0]);
                    g += bflo(qw.x) * ka.x + bfhi(qw.x) * ka.y + bflo(qw.y) * ka.z + bfhi(qw.y) * ka.w + bflo(qw.z) * kb.x + bfhi(qw.z) * kb.y + bflo(qw.w) * kb.z + bfhi(qw.w) * kb.w; }
                gt[n] = xhalf_sum(g); } }
#pragma unroll
        for (int n = 0; n < 7; ++n) if (n < own) { int rank = 0;
#pragma unroll
            for (int m2 = 0; m2 < 7; ++m2) if (m2 != n && m2 < own) rank += ((gt[m2] > gt[n]) || (gt[m2] == gt[n] && m2 < n)) ? 1 : 0;
            if (rank < 3) selbits |= 1u << n; }
    }
    float cq2 = 0.f;
    if (MODE == 2) cq2 = cg[tq] * LOG2E;
    int it0 = 0;
    if (MODE == 2) { const int q0u = q0w - 32 * F.wave; const float cq0 = cg[q0u];
        bool pred = true; if (lane < nt) pred = (cq0 - cg[64 * lane + 63]) * LOG2E >= FOX_SKIP;
        const unsigned long long bm = __ballot(pred); it0 = __builtin_ctzll(bm); if (it0 > nt - 1) it0 = nt - 1; }
    bool wdone = false;
    LAS int* flg = (LAS int*)(L + L_FLAG);
    v4u kreg, vreg; float creg = 0.f; unsigned long long mreg = 0ull;
    {   const int t = (MODE == 0) ? nt - 1 : it0;
        kreg = kg[(size_t)t * 8192]; vreg = vg[(size_t)t * 8192];
        if (MODE == 2 && tid < 64) creg = cg[64 * t + tid];
        if (MODE == 3) mreg = mrow[t < 32 ? t : 31]; }
    const int vboff = (4 * hi + ((lane & 15) >> 2)) * KS + ((lane >> 4) & 1) * 32 + (lane & 3) * 8;
#pragma unroll 1
    for (int it = it0; it < nt; ++it) {
        const int t = (MODE == 0) ? nt - 1 - it : it, buf = it & 1;
        if (MODE == 0 && lane == 0) flg[buf * 8 + F.wave] = wdone ? 1 : 0;
        *(LAS v4u*)(L + L_K + buf * TILE_B + sdst) = kreg; *(LAS v4u*)(L + L_V + buf * TILE_B + sdst) = vreg;
        if (MODE == 2 && tid < 64) ((LAS float*)(L + L_C + buf * 256))[tid] = creg * LOG2E;
        const unsigned long long mb = mreg;
        __syncthreads();
        if (it + 1 < nt) { const int tn = (MODE == 0) ? nt - 2 - it : it + 1;
            kreg = kg[(size_t)tn * 8192]; vreg = vg[(size_t)tn * 8192];
            if (MODE == 2 && tid < 64) creg = cg[64 * tn + tid];
            if (MODE == 3) mreg = mrow[tn]; }
        if (MODE == 0) { typedef int i32x4_t __attribute__((ext_vector_type(4))); const i32x4_t fa = *(const LAS i32x4_t*)(flg + buf * 8), fb = *(const LAS i32x4_t*)(flg + buf * 8 + 4);
            if ((fa.x & fa.y & fa.z & fa.w & fb.x & fb.y & fb.z & fb.w) != 0) break; }
        if (t > tw || wdone) continue;
        const bool moba_other = (MODE == 1) && ((t >> 2) != own);
        if (moba_other && __ballot((selbits >> (t >> 2)) & 1u) == 0ull) continue;
        const LAS unsigned char* Kt = L + L_K + buf * TILE_B; const LAS unsigned char* Vt = L + L_V + buf * TILE_B;
        f32x16 p0, p1;
#pragma unroll
        for (int r = 0; r < 16; ++r) { p0[r] = 0.f; p1[r] = 0.f; }
#pragma unroll
        for (int d0 = 0; d0 < 4; ++d0) {
            const bf16x8 a0 = *(const LAS bf16x8*)(Kt + r32 * KS + d0 * 32 + hi * 16);
            const bf16x8 a1 = *(const LAS bf16x8*)(Kt + (r32 + 32) * KS + d0 * 32 + hi * 16);
            p0 = __builtin_amdgcn_mfma_f32_32x32x16_bf16(a0, qf[d0], p0, 0, 0, 0);
            p1 = __builtin_amdgcn_mfma_f32_32x32x16_bf16(a1, qf[d0], p1, 0, 0, 0);
        }
        const int kbase = 64 * t;
        const bool diag = (kbase + 63 >= q0w);
        if (MODE == 0) {
            float Lv[32], Gs[8];
#pragma unroll
            for (int g = 0; g < 8; ++g) { float gs = 0.f;
#pragma unroll
                for (int i = 0; i < 4; ++i) { const int r = 4 * (g & 3) + i; const float z2 = ((g < 4) ? p0[r] : p1[r]) * SC2;
                    const float sp = fmaxf(z2, 0.f) + __builtin_amdgcn_logf(1.0f + __builtin_amdgcn_exp2f(-fabsf(z2)));
                    const int key = kbase + 8 * g + 4 * hi + i; const bool valid = !diag || (key < tq);
                    Lv[4 * g + i] = valid ? -sp : 0.f; gs += Lv[4 * g + i];
                    const float ls = valid ? (z2 - sp) : NINF;
                    if (g < 4) p0[r] = ls; else p1[r] = ls; }
                Gs[g] = gs; }
            float GP[8], T[8]; float suf = 0.f;
#pragma unroll
            for (int g = 0; g < 8; ++g) GP[g] = xhalf_sum(Gs[g]);
#pragma unroll
            for (int g = 7; g >= 0; --g) { T[g] = carry + suf + (hi == 0 ? GP[g] - Gs[g] : 0.f); suf += GP[g]; }
            carry += suf;
            wdone = (__ballot(carry > SB_DONE) == 0ull);
#pragma unroll
            for (int g = 0; g < 8; ++g) { float run = 0.f;
#pragma unroll
                for (int i = 3; i >= 0; --i) { const int r = 4 * (g & 3) + i; const float ls = (g < 4) ? p0[r] : p1[r];
                    const float w = __builtin_amdgcn_exp2f(ls + (T[g] + run)); run += Lv[4 * g + i];
                    if (g < 4) p0[r] = w; else p1[r] = w; } }
        } else if (!diag && (MODE == 2 || q0w - (kbase + 63) >= 128)) {
            typedef float f2 __attribute__((ext_vector_type(2)));
            float sub, mn;
            if (MODE == 2) {
                const LAS float* Ct = (const LAS float*)(L + L_C + buf * 256);
#pragma unroll
                for (int g = 0; g < 4; ++g) { const f32x4 ca = *(const LAS f32x4*)(Ct + 8 * g + 4 * hi), cb = *(const LAS f32x4*)(Ct + 32 + 8 * g + 4 * hi);
                    const f2 a0 = (f2){p0[4 * g], p0[4 * g + 1]} * SC2 - (f2){ca[0], ca[1]}, a1 = (f2){p0[4 * g + 2], p0[4 * g + 3]} * SC2 - (f2){ca[2], ca[3]};
                    const f2 b0 = (f2){p1[4 * g], p1[4 * g + 1]} * SC2 - (f2){cb[0], cb[1]}, b1 = (f2){p1[4 * g + 2], p1[4 * g + 3]} * SC2 - (f2){cb[2], cb[3]};
                    p0[4 * g] = a0.x; p0[4 * g + 1] = a0.y; p0[4 * g + 2] = a1.x; p0[4 * g + 3] = a1.y; p1[4 * g] = b0.x; p1[4 * g + 1] = b0.y; p1[4 * g + 2] = b1.x; p1[4 * g + 3] = b1.y; }
                float rm = fmaxf(fmaxf(p0[0], p1[0]), fmaxf(p0[1], p1[1]));
#pragma unroll
                for (int r = 2; r < 16; r += 2) rm = fmaxf(rm, fmaxf(fmaxf(p0[r], p1[r]), fmaxf(p0[r + 1], p1[r + 1])));
                rm = xhalf_max(rm);
                mn = fmaxf(m, rm + cq2); sub = cq2 - mn;
#pragma unroll
                for (int r = 0; r < 16; r += 2) { const f2 a = (f2){p0[r], p0[r + 1]} + sub, b = (f2){p1[r], p1[r + 1]} + sub;
                    p0[r] = __builtin_amdgcn_exp2f(a.x); p0[r + 1] = __builtin_amdgcn_exp2f(a.y); p1[r] = __builtin_amdgcn_exp2f(b.x); p1[r + 1] = __builtin_amdgcn_exp2f(b.y); }
            } else {
                float rm = fmaxf(fmaxf(p0[0], p1[0]), fmaxf(p0[1], p1[1]));
#pragma unroll
                for (int r = 2; r < 16; r += 2) rm = fmaxf(rm, fmaxf(fmaxf(p0[r], p1[r]), fmaxf(p0[r + 1], p1[r + 1])));
                rm = xhalf_max(rm);
                float bfar = lut2[128];
                if (moba_other && ((selbits >> (t >> 2)) & 1u) == 0u) bfar = NINF;
                mn = fmaxf(m, rm * SC2 + bfar); sub = bfar - mn;
#pragma unroll
                for (int r = 0; r < 16; r += 2) { const f2 a = (f2){p0[r], p0[r + 1]} * SC2 + sub, b = (f2){p1[r], p1[r + 1]} * SC2 + sub;
                    p0[r] = __builtin_amdgcn_exp2f(a.x); p0[r + 1] = __builtin_amdgcn_exp2f(a.y); p1[r] = __builtin_amdgcn_exp2f(b.x); p1[r + 1] = __builtin_amdgcn_exp2f(b.y); }
                if (MODE == 3) {
                    const int w0 = (int)(unsigned)(mb >> (4 * hi)), w1 = (int)(unsigned)(mb >> (32 + 4 * hi));
#pragma unroll
                    for (int r = 0; r < 16; ++r) { const int bit = (r & 3) + 8 * (r >> 2);
                        p0[r] = __uint_as_float(__float_as_uint(p0[r]) & (unsigned)__builtin_amdgcn_sbfe(w0, bit, 1)); p1[r] = __uint_as_float(__float_as_uint(p1[r]) & (unsigned)__builtin_amdgcn_sbfe(w1, bit, 1)); } }
            }
            const float alpha = __builtin_amdgcn_exp2f(m - mn); m = mn;
            f2 acc2 = (f2){0.f, 0.f};
#pragma unroll
            for (int r = 0; r < 16; r += 2) { acc2 += (f2){p0[r], p0[r + 1]}; acc2 += (f2){p1[r], p1[r + 1]}; }
            lsum = lsum * alpha + (acc2.x + acc2.y);
            if (__ballot(alpha != 1.0f) != 0ull) {
#pragma unroll
                for (int r = 0; r < 16; ++r) { o0[r] *= alpha; o1[r] *= alpha; } }
        } else {
            if (MODE == 2) {
                const LAS float* Ct = (const LAS float*)(L + L_C + buf * 256);
#pragma unroll
                for (int g = 0; g < 4; ++g) { const f32x4 ca = *(const LAS f32x4*)(Ct + 8 * g + 4 * hi), cb = *(const LAS f32x4*)(Ct + 32 + 8 * g + 4 * hi);
#pragma unroll
                    for (int i = 0; i < 4; ++i) { p0[4 * g + i] = p0[4 * g + i] * SC2 + (cq2 - ca[i]); p1[4 * g + i] = p1[4 * g + i] * SC2 + (cq2 - cb[i]); } }
            } else {
                if (q0w - (kbase + 63) >= 128) { const float bfar = lut2[128];
#pragma unroll
                    for (int r = 0; r < 16; ++r) { p0[r] = p0[r] * SC2 + bfar; p1[r] = p1[r] * SC2 + bfar; }
                } else {
#pragma unroll
                    for (int r = 0; r < 16; ++r) { int d0_ = tq - (kbase + crow(r, hi)), d1_ = d0_ - 32;
                        d0_ = d0_ < 0 ? 0 : (d0_ > 128 ? 128 : d0_); d1_ = d1_ < 0 ? 0 : (d1_ > 128 ? 128 : d1_);
                        p0[r] = p0[r] * SC2 + lut2[d0_]; p1[r] = p1[r] * SC2 + lut2[d1_]; }
                }
            }
            if (diag) {
#pragma unroll
                for (int r = 0; r < 16; ++r) { const int key = kbase + crow(r, hi); if (key > tq) p0[r] = NINF; if (key + 32 > tq) p1[r] = NINF; }
            }
            if (moba_other) { if (((selbits >> (t >> 2)) & 1u) == 0u) {
#pragma unroll
                    for (int r = 0; r < 16; ++r) { p0[r] = NINF; p1[r] = NINF; } } }
            if (MODE == 3) { const unsigned w0 = (unsigned)(mb >> (4 * hi)), w1 = (unsigned)(mb >> (32 + 4 * hi));
#pragma unroll
                for (int r = 0; r < 16; ++r) { const int bit = (r & 3) + 8 * (r >> 2); if (((w0 >> bit) & 1u) == 0u) p0[r] = NINF; if (((w1 >> bit) & 1u) == 0u) p1[r] = NINF; } }
            float rm = fmaxf(p0[0], p1[0]);
#pragma unroll
            for (int r = 1; r < 16; ++r) rm = fmaxf(rm, fmaxf(p0[r], p1[r]));
            rm = xhalf_max(rm);
            const float mn = fmaxf(m, rm), alpha = __builtin_amdgcn_exp2f(m - mn); m = mn;
            float ps = 0.f;
#pragma unroll
            for (int r = 0; r < 16; ++r) { p0[r] = __builtin_amdgcn_exp2f(p0[r] - mn); p1[r] = __builtin_amdgcn_exp2f(p1[r] - mn); ps += p0[r] + p1[r]; }
            lsum = lsum * alpha + ps;
            if (__ballot(alpha != 1.0f) != 0ull) {
#pragma unroll
                for (int r = 0; r < 16; ++r) { o0[r] *= alpha; o1[r] *= alpha; } }
        }
        const LAS unsigned char* vb = Vt + vboff;
#pragma unroll
        for (int pp = 0; pp < 2; ++pp)
#pragma unroll
            for (int s = 0; s < 2; ++s) {
                const bf16x8 bfrag = pack8(pp == 0 ? p0 : p1, s);
#pragma unroll
                for (int d0 = 0; d0 < 2; ++d0) {
                    const s16x4 lo = vtr(vb + (32 * pp + 16 * s) * KS + 64 * d0), hh = vtr(vb + (32 * pp + 16 * s + 8) * KS + 64 * d0);
                    const bf16x8 afrag = (bf16x8){lo[0], lo[1], lo[2], lo[3], hh[0], hh[1], hh[2], hh[3]};
                    if (d0 == 0) o0 = __builtin_amdgcn_mfma_f32_32x32x16_bf16(afrag, bfrag, o0, 0, 0, 0); else o1 = __builtin_amdgcn_mfma_f32_32x32x16_bf16(afrag, bfrag, o1, 0, 0, 0);
                }
            }
    }
    float inv = 1.0f;
    if (MODE != 0) inv = 1.0f / xhalf_sum(lsum);
    typedef unsigned u32x2 __attribute__((ext_vector_type(2)));
    GAS unsigned short* op = (GAS unsigned short*)(Obase + rowq * 1024 + qcol + 4 * hi);
#pragma unroll
    for (int g = 0; g < 4; ++g) { u32x2 w0, w1;
        w0.x = cvtpk(o0[4 * g] * inv, o0[4 * g + 1] * inv); w0.y = cvtpk(o0[4 * g + 2] * inv, o0[4 * g + 3] * inv);
        w1.x = cvtpk(o1[4 * g] * inv, o1[4 * g + 1] * inv); w1.y = cvtpk(o1[4 * g + 2] * inv, o1[4 * g + 3] * inv);
        *(GAS u32x2*)(op + 8 * g) = w0; *(GAS u32x2*)(op + 32 + 8 * g) = w1; }
    __syncthreads();
}
}
__device__ __forceinline__ void p_attn_mfma(Frame& F, bf16* Obase) {
    const int wave = F.wave;
#pragma unroll 1
    for (int idx = F.vcu; idx < 256; idx += F.G) {
        const int bh = idx >> 2, s = idx & 3, b = bh >> 2, h = bh & 3; const size_t rb = (size_t)b * SEQ * 1024;
#pragma unroll 1
        for (int k = 0; k < 2; ++k) { const int qb = k ? 7 - s : s;
            att::unit<0>(F, b, h, 256 * qb + 32 * wave, 4 * qb + 4, F_PK + rb + h * 64, F_PV + rb + h * 64, h * 64, Obase); }
#pragma unroll 1
        for (int k = 0; k < 2; ++k) { const int qb = k ? 7 - s : s;
            att::unit<1>(F, b, h, 256 * qb + 32 * wave, 4 * qb + 4, F_PK + rb + 256 + h * 64, F_PV + rb + 256 + h * 64, 256 + h * 64, Obase); }
#pragma unroll 1
        for (int k = 0; k < 2; ++k) { const int qb = k ? 7 - s : s;
            att::unit<2>(F, b, h, 256 * qb + 32 * wave, 4 * qb + 4, F_PK + rb + 512 + h * 64, F_PV + rb + 512 + h * 64, 512 + h * 64, Obase); }
    }
#pragma unroll 1
    for (int idx = F.vcu; idx < 256; idx += F.G) {
        const int b = idx >> 4, s = idx & 15; const size_t rb = (size_t)b * SEQ * 1024;
#pragma unroll 1
        for (int k = 0; k < 2; ++k) { const int j = k ? 31 - s : s;
            att::unit<3>(F, b, wave & 3, 64 * j + 32 * (wave >> 2), j + 1, F_PK + rb + 768, F_PK + rb + 832, 768 + (wave & 3) * 64, Obase); }
    }
}

__device__ __forceinline__ void idx_item(Frame& F, int b, int pr, const LAS unsigned char* KL) {
    typedef short bf16x8 __attribute__((ext_vector_type(8)));
    const int lane = F.lane, c16 = lane & 15, fq = lane >> 4, half = lane >> 5;
    const int t0 = 2 * pr, tqh = t0 + half;
    GAS unsigned long long* mrow0 = (GAS unsigned long long*)F_MASK + ((size_t)b * SEQ + t0) * 32;
    if (t0 + 1 < 256) {
        unsigned long long m0 = 0ull, m1 = 0ull; const int lo = 64 * lane;
        if (t0 >= lo + 63) m0 = ~0ull; else if (t0 >= lo) m0 = (2ull << (t0 - lo)) - 1ull;
        if (t0 + 1 >= lo + 63) m1 = ~0ull; else if (t0 + 1 >= lo) m1 = (2ull << (t0 + 1 - lo)) - 1ull;
        if (lane < 32) { mrow0[lane] = m0; mrow0[32 + lane] = m1; }
        return;
    }
    const bf16x8 af = *(const GAS bf16x8*)(F_PV + ((size_t)b * SEQ + t0 + (c16 >> 3)) * 1024 + 768 + (c16 & 7) * 32 + 8 * fq);
    typedef short s16x4_t __attribute__((ext_vector_type(4)));
    s16x4_t Ae, Ao;
    {   typedef unsigned u32x2 __attribute__((ext_vector_type(2)));
        const u32x2 raw = *(const GAS u32x2*)(F_PK + ((size_t)b * SEQ + t0 + (fq >> 1)) * 1024 + 928 + 4 * (fq & 1));
        const bool evl = (fq < 2) ? (c16 == 0) : (c16 == 8), odl = (fq < 2) ? (c16 == 4) : (c16 == 12);
        u32x2 we, wo; we.x = evl ? raw.x : 0u; we.y = evl ? raw.y : 0u; wo.x = odl ? raw.x : 0u; wo.y = odl ? raw.y : 0u;
        Ae = __builtin_bit_cast(s16x4_t, we); Ao = __builtin_bit_cast(s16x4_t, wo); }
    const int nk = ((t0 + 1) >> 4) + 1;
    const int l31 = lane & 31;
    unsigned uk[64];
    const LAS bf16x8* kp = (const LAS bf16x8*)(KL + c16 * 64 + fq * 16);
#pragma unroll
    for (int grp = 0; grp < 16; ++grp) {
        if (8 * grp < nk) {
            bf16x8 bfr[8];
#pragma unroll
            for (int i = 0; i < 8; ++i) bfr[i] = kp[(8 * grp + i) * 64];
#pragma unroll
            for (int i = 0; i < 8; i += 2) { const int kpair = 4 * grp + (i >> 1);
                const f32x4 z4 = (f32x4){0.f, 0.f, 0.f, 0.f};
                const f32x4 de = __builtin_amdgcn_mfma_f32_16x16x32_bf16(af, bfr[i], z4, 0, 0, 0), dd = __builtin_amdgcn_mfma_f32_16x16x32_bf16(af, bfr[i + 1], z4, 0, 0, 0);
                typedef unsigned u32x2 __attribute__((ext_vector_type(2)));
                u32x2 re, ro;
                re.x = att::cvtpk(__int_as_float(max(__float_as_int(de.x), 0)), __int_as_float(max(__float_as_int(de.y), 0))); re.y = att::cvtpk(__int_as_float(max(__float_as_int(de.z), 0)), __int_as_float(max(__float_as_int(de.w), 0)));
                ro.x = att::cvtpk(__int_as_float(max(__float_as_int(dd.x), 0)), __int_as_float(max(__float_as_int(dd.y), 0))); ro.y = att::cvtpk(__int_as_float(max(__float_as_int(dd.z), 0)), __int_as_float(max(__float_as_int(dd.w), 0)));
                f32x4 sc = __builtin_amdgcn_mfma_f32_16x16x16bf16_1k(Ae, __builtin_bit_cast(s16x4_t, re), z4, 0, 0, 0);
                sc = __builtin_amdgcn_mfma_f32_16x16x16bf16_1k(Ao, __builtin_bit_cast(s16x4_t, ro), sc, 0, 0, 0);
                const int bits = (int)__float_as_uint(sc.x); unsigned uu = (unsigned)bits ^ ((unsigned)(bits >> 31) | 0x80000000u);
                if (32 * kpair + 31 > t0) { if (32 * kpair + l31 > tqh) uu = 0u; }
                uk[kpair] = uu; }
        } else {
#pragma unroll
            for (int i = 0; i < 4; ++i) uk[4 * grp + i] = 0u;
        }
    }
#define IDX_TR_STEP(A, k, j, m) { const unsigned t_ = ((A[k] >> (j)) ^ A[(k) + (j)]) & (m); A[(k) + (j)] ^= t_; A[k] ^= t_ << (j); }
#pragma unroll
    for (int half_ = 0; half_ < 2; ++half_) {
#pragma unroll
        for (int k = 0; k < 16; ++k) IDX_TR_STEP(uk, 32 * half_ + k, 16, 0x0000FFFFu)
#pragma unroll
        for (int k = 0; k < 32; ++k) if ((k & 8) == 0) IDX_TR_STEP(uk, 32 * half_ + k, 8, 0x00FF00FFu)
#pragma unroll
        for (int k = 0; k < 32; ++k) if ((k & 4) == 0) IDX_TR_STEP(uk, 32 * half_ + k, 4, 0x0F0F0F0Fu)
#pragma unroll
        for (int k = 0; k < 32; ++k) if ((k & 2) == 0) IDX_TR_STEP(uk, 32 * half_ + k, 2, 0x33333333u)
#pragma unroll
        for (int k = 0; k < 32; ++k) if ((k & 1) == 0) IDX_TR_STEP(uk, 32 * half_ + k, 1, 0x55555555u)
    }
#undef IDX_TR_STEP
    unsigned cl = ~0u, ch = ~0u, sl = 0u, sh = 0u;
    int need = 256, ncand = 2048;
#pragma unroll
    for (int b = 31; b >= 0; --b) {
        if (__ballot(ncand != need) == 0ull) break;
        const unsigned ol = cl & uk[b], oh = ch & uk[32 + b];
        int n = __popc(ol) + __popc(oh);
        n += __builtin_amdgcn_update_dpp(0, n, 0x111, 0xf, 0xf, true); n += __builtin_amdgcn_update_dpp(0, n, 0x112, 0xf, 0xf, true);
        n += __builtin_amdgcn_update_dpp(0, n, 0x114, 0xf, 0xf, true); n += __builtin_amdgcn_update_dpp(0, n, 0x118, 0xf, 0xf, true);
        const int n0 = __builtin_amdgcn_readlane(n, 15) + __builtin_amdgcn_readlane(n, 31), n1 = __builtin_amdgcn_readlane(n, 47) + __builtin_amdgcn_readlane(n, 63);
        const int c1 = half ? n1 : n0;
        {
            const bool act = ncand != need, ge = c1 >= need, take = act && ge, drop = act && !ge;
            const unsigned dl = drop ? ol : 0u, dh = drop ? oh : 0u; const int dc = drop ? c1 : 0;
            sl |= dl; sh |= dh;
            cl = take ? ol : (cl & ~dl); ch = take ? oh : (ch & ~dh);
            need -= dc; ncand = take ? c1 : ncand - dc; }
    }
#define IDX_BFLY(X, S, M) { const unsigned y_ = (unsigned)__builtin_amdgcn_ds_bpermute((lz ^ (S)) << 2, (int)(X)); X = ((lz & (S)) == 0) ? ((X & (M)) | ((y_ & (M)) << (S))) : (((y_ & ~(M)) >> (S)) | (X & ~(M))); }
    {   int lz = lane; asm volatile("" : "+v"(lz));
        IDX_BFLY(sl, 1, 0x55555555u) IDX_BFLY(sh, 1, 0x55555555u) IDX_BFLY(cl, 1, 0x55555555u) IDX_BFLY(ch, 1, 0x55555555u)
        IDX_BFLY(sl, 2, 0x33333333u) IDX_BFLY(sh, 2, 0x33333333u) IDX_BFLY(cl, 2, 0x33333333u) IDX_BFLY(ch, 2, 0x33333333u)
        IDX_BFLY(sl, 4, 0x0F0F0F0Fu) IDX_BFLY(sh, 4, 0x0F0F0F0Fu) IDX_BFLY(cl, 4, 0x0F0F0F0Fu) IDX_BFLY(ch, 4, 0x0F0F0F0Fu)
        IDX_BFLY(sl, 8, 0x00FF00FFu) IDX_BFLY(sh, 8, 0x00FF00FFu) IDX_BFLY(cl, 8, 0x00FF00FFu) IDX_BFLY(ch, 8, 0x00FF00FFu)
        IDX_BFLY(sl, 16, 0x0000FFFFu) IDX_BFLY(sh, 16, 0x0000FFFFu) IDX_BFLY(cl, 16, 0x0000FFFFu) IDX_BFLY(ch, 16, 0x0000FFFFu)
        unsigned outl = sl | cl, outh = sh | ch;
        if (__ballot(ncand != need) != 0ull) {
            const int r = lz & 31, pcl = __popc(cl), pch = __popc(ch); int inc = pcl | (pch << 16);
#pragma unroll
            for (int o = 1; o < 32; o <<= 1) { const int n_ = __builtin_amdgcn_ds_bpermute(((lz - o) & 63) << 2, inc); if (r >= o) inc += n_; }
            const int tot = __builtin_amdgcn_ds_bpermute((lz | 31) << 2, inc);
            const int before_l = (inc & 0xffff) - pcl, before_h = (tot & 0xffff) + (inc >> 16) - pch;
            int tl = need - before_l; tl = tl < 0 ? 0 : (tl > pcl ? pcl : tl); int th = need - before_h; th = th < 0 ? 0 : (th > pch ? pch : th);
            unsigned el = cl, kl = 0u; for (int k = 0; k < tl; ++k) { const unsigned low = el & (0u - el); kl |= low; el ^= low; }
            unsigned eh = ch, kh = 0u; for (int k = 0; k < th; ++k) { const unsigned low = eh & (0u - eh); kh |= low; eh ^= low; }
            outl = sl | kl; outh = sh | kh; }
        GAS unsigned* mw = (GAS unsigned*)(mrow0 + 32 * half) + (lz & 31);
        mw[0] = outl; mw[32] = outh; }
#undef IDX_BFLY
}
__device__ __forceinline__ void p_prep(Frame& F, int l) {
    const int gw = F.vcu * NWAVES + F.wave, NGW = F.G * NWAVES, lane = F.lane;
    for (int it = gw; it < NB * 4; it += NGW) {
        const int b = it >> 2, h = it & 3; const float bfv = inp(5)[l * 4 + h];
        float v[32]; float run = 0.f;
#pragma unroll
        for (int i = 0; i < 32; ++i) { const float x = bf2f(*(const GAS unsigned short*)(F_PK + ((size_t)b * SEQ + lane * 32 + i) * 1024 + 936 + h)) + bfv;
            run += fminf(x, 0.f) - 0.6931471805599453f * __builtin_amdgcn_logf(1.0f + __builtin_amdgcn_exp2f(-1.4426950408889634f * fabsf(x))); v[i] = run; }
        float incl = run;
#pragma unroll
        for (int o = 1; o < 64; o <<= 1) { const float n = __builtin_bit_cast(float, __builtin_amdgcn_ds_bpermute(((lane - o) & 63) << 2, __builtin_bit_cast(int, incl))); if (lane >= o) incl += n; }
        const float off = incl - run;
        GAS float* cp = (GAS float*)F_CUM + (size_t)it * SEQ + lane * 32;
#pragma unroll
        for (int i = 0; i < 32; ++i) cp[i] = v[i] + off;
    }
    for (int it = gw; it < NB * 4 * 8; it += NGW) {
        const int n = it & 7, h = (it >> 3) & 3, b = it >> 5;
        const GAS v4u* kp = (const GAS v4u*)(F_PK + ((size_t)b * SEQ + n * 256 + (lane >> 3)) * 1024 + 256 + h * 64 + (lane & 7) * 8);
        float s[8];
#pragma unroll
        for (int e = 0; e < 8; ++e) s[e] = 0.f;
#pragma unroll 8
        for (int j = 0; j < 32; ++j) { const v4u r = kp[(size_t)j * (8 * 1024 / 8)];
            s[0] += bflo(r.x); s[1] += bfhi(r.x); s[2] += bflo(r.y); s[3] += bfhi(r.y); s[4] += bflo(r.z); s[5] += bfhi(r.z); s[6] += bflo(r.w); s[7] += bfhi(r.w); }
#pragma unroll
        for (int e = 0; e < 8; ++e) { s[e] += shx(s[e], lane, 8); s[e] += shx(s[e], lane, 16); s[e] += shx(s[e], lane, 32); }
        if (lane < 8) { GAS f32x4* o = (GAS f32x4*)((GAS float*)F_KMEAN + (size_t)it * 64 + lane * 8);
            o[0] = (f32x4){s[0], s[1], s[2], s[3]} * (1.f / 256.f); o[1] = (f32x4){s[4], s[5], s[6], s[7]} * (1.f / 256.f); }
    }
#pragma unroll 1
    for (int it = gw, k = 0; it < NB * (SEQ / 2); it += NGW, ++k) { const int b = it >> 10; int pr = it & 1023; if (k & 1) pr = 1023 - pr;
        const int prw0 = (it - F.wave) & 1023, prmax = (k & 1) ? 1023 - prw0 : prw0 + 7; int nkeys = (2 * prmax + 2 + 15) & ~15; if (nkeys > SEQ) nkeys = SEQ;
        LAS unsigned char* KL = F.lds + RING_OFF;
        __syncthreads();
        if (2 * prmax + 1 >= 256) {
            for (int p0 = F.tid; p0 < nkeys * 4; p0 += 4 * 512) { v4u v[4];
#pragma unroll
                for (int u = 0; u < 4; ++u) { const int p_ = p0 + u * 512; if (p_ < nkeys * 4) v[u] = *(const GAS v4u*)(F_PK + ((size_t)b * SEQ + (p_ >> 2)) * 1024 + 896 + (p_ & 3) * 8); }
#pragma unroll
                for (int u = 0; u < 4; ++u) { const int p_ = p0 + u * 512; if (p_ < nkeys * 4) *(LAS v4u*)(KL + (p_ >> 2) * 64 + (p_ & 3) * 16) = v[u]; } } }
        __syncthreads();
        idx_item(F, b, pr, KL); }
}

__device__ __forceinline__ void attn_item(Frame& F, int mode, int b, int h, int qblk) {
    const int lane = F.lane, ql = lane & 31, hf = lane >> 5;
    LAS unsigned char* Ks = F.lds + RING_OFF + F.wave * 16384; LAS unsigned char* Vs = Ks + 8192;
    LAS float* cs = (LAS float*)(F.lds + AUX_OFF + F.wave * 256);
    const LAS float* lut = (const LAS float*)(F.lds + LUT_OFF) + ((mode == 3 ? 4 : 0) + h) * LUT_STRIDE;
    const int t0 = qblk * 32, t = t0 + ql; const size_t rowq = (size_t)b * SEQ + t;
    int qcol; const bf16* Kb; const bf16* Vb;
    if (mode == 0) { qcol = h * 64; Kb = F_PK + h * 64; Vb = F_PV + h * 64; }
    else if (mode == 1) { qcol = 256 + h * 64; Kb = F_PK + 256 + h * 64; Vb = F_PV + 256 + h * 64; }
    else if (mode == 2) { qcol = 512 + h * 64; Kb = F_PK + 512 + h * 64; Vb = F_PV + 512 + h * 64; }
    else { qcol = 768 + h * 64; Kb = F_PK + 768; Vb = F_PK + 832; }
    float qv[32];
    {   const GAS v4u* qp = (const GAS v4u*)(F_PQ + rowq * 1024 + qcol + 32 * hf);
#pragma unroll
        for (int i = 0; i < 4; ++i) { const v4u r = qp[i]; qv[8 * i + 0] = 0.125f * bflo(r.x); qv[8 * i + 1] = 0.125f * bfhi(r.x); qv[8 * i + 2] = 0.125f * bflo(r.y); qv[8 * i + 3] = 0.125f * bfhi(r.y);
            qv[8 * i + 4] = 0.125f * bflo(r.z); qv[8 * i + 5] = 0.125f * bfhi(r.z); qv[8 * i + 6] = 0.125f * bflo(r.w); qv[8 * i + 7] = 0.125f * bfhi(r.w); }
    }
    float o[32];
#pragma unroll
    for (int d = 0; d < 32; ++d) o[d] = 0.f;
    float mx = -1e30f, lsum = 0.f, E = 0.f;
    const int own = qblk >> 3; unsigned selbits = 0u;
    if (mode == 1) {
        float gt[7];
#pragma unroll
        for (int n = 0; n < 7; ++n) { gt[n] = 0.f;
            if (n < own) { const GAS f32x4* kmp = vptr((const GAS f32x4*)((const GAS float*)F_KMEAN + ((size_t)((b * 4 + h) * 8 + n)) * 64)) + 8 * hf; float g = 0.f;
#pragma unroll
                for (int i = 0; i < 8; ++i) { const f32x4 km = kmp[i]; g += qv[4 * i] * km.x + qv[4 * i + 1] * km.y + qv[4 * i + 2] * km.z + qv[4 * i + 3] * km.w; }
                gt[n] = g + __shfl_xor(g, 32); } }
#pragma unroll
        for (int n = 0; n < 7; ++n) if (n < own) { int rank = 0;
#pragma unroll
            for (int m2 = 0; m2 < 7; ++m2) if (m2 != n && m2 < own) rank += ((gt[m2] > gt[n]) || (gt[m2] == gt[n] && m2 < n)) ? 1 : 0;
            if (rank < 3) selbits |= 1u << n; }
    }
    float cq = 0.f;
    if (mode == 2) cq = ((const GAS float*)F_CUM)[(size_t)(b * 4 + h) * SEQ + t];
    const GAS unsigned long long* mrow = (const GAS unsigned long long*)F_MASK + rowq * 32;
    const int nch = (qblk >> 1) + 1;
#pragma unroll 1
    for (int ci = 0; ci < nch; ++ci) {
        const int c = (mode == 0) ? (nch - 1 - ci) : ci; const int nblk = c >> 2;
        if (mode == 1 && nblk != own && __ballot((selbits >> nblk) & 1u) == 0ull) continue;
        asm volatile("s_waitcnt lgkmcnt(0)" ::: "memory");
        const size_t krow0 = (size_t)b * SEQ + 64 * c;
#pragma unroll
        for (int i = 0; i < 8; ++i) { const int r = i * 8 + (lane >> 3), pc = lane & 7;
            const v4u kk = *(const GAS v4u*)(Kb + (krow0 + r) * 1024 + pc * 8); const v4u vv = *(const GAS v4u*)(Vb + (krow0 + r) * 1024 + pc * 8);
            *(LAS v4u*)(Ks + r * 128 + pc * 16) = kk; *(LAS v4u*)(Vs + r * 128 + pc * 16) = vv; }
        if (mode == 2) cs[lane] = ((const GAS float*)F_CUM)[(size_t)(b * 4 + h) * SEQ + 64 * c + lane];
        unsigned long long mb = ~0ull; if (mode == 3) mb = mrow[c];
        asm volatile("s_waitcnt vmcnt(0) lgkmcnt(0)" ::: "memory");
        const bool selblk = (mode != 1) || (nblk == own) || (((selbits >> nblk) & 1u) != 0u);
#pragma unroll 1
        for (int jj = 0; jj < 64; ++jj) {
            const int j = (mode == 0) ? 63 - jj : jj; const int s = 64 * c + j;
            if (s > t0 + 31) continue;
            float dot = 0.f;
#pragma unroll
            for (int i = 0; i < 4; ++i) { const v4u kk = *(const LAS v4u*)(Ks + j * 128 + hf * 64 + i * 16);
                dot += qv[8 * i + 0] * bflo(kk.x) + qv[8 * i + 1] * bfhi(kk.x) + qv[8 * i + 2] * bflo(kk.y) + qv[8 * i + 3] * bfhi(kk.y)
                     + qv[8 * i + 4] * bflo(kk.z) + qv[8 * i + 5] * bfhi(kk.z) + qv[8 * i + 6] * bflo(kk.w) + qv[8 * i + 7] * bfhi(kk.w); }
            dot += __shfl_xor(dot, 32);
            float p;
            if (mode == 0) {
                const bool valid = s < t;
                const float sp = fmaxf(dot, 0.f) + __logf(1.0f + __expf(-fabsf(dot)));
                p = valid ? __expf(dot - sp + E) : 0.f; E += valid ? -sp : 0.f;
            } else {
                const bool valid = (s <= t) && selblk && (((mb >> j) & 1ull) != 0ull);
                float logit = dot;
                if (mode == 2) logit += cq - cs[j];
                if (mode == 1 || mode == 3) { int dist = t - s; dist = dist < 0 ? 0 : (dist > 128 ? 128 : dist); logit += lut[dist]; }
                if (valid && logit > mx + 8.0f) { const float f = __expf(mx - logit); lsum *= f;
#pragma unroll
                    for (int d = 0; d < 32; ++d) o[d] *= f;
                    mx = logit; }
                p = valid ? __expf(logit - mx) : 0.f; lsum += p;
            }
#pragma unroll
            for (int i = 0; i < 4; ++i) { const v4u vv = *(const LAS v4u*)(Vs + j * 128 + hf * 64 + i * 16);
                o[8 * i + 0] += p * bflo(vv.x); o[8 * i + 1] += p * bfhi(vv.x); o[8 * i + 2] += p * bflo(vv.y); o[8 * i + 3] += p * bfhi(vv.y);
                o[8 * i + 4] += p * bflo(vv.z); o[8 * i + 5] += p * bfhi(vv.z); o[8 * i + 6] += p * bflo(vv.w); o[8 * i + 7] += p * bfhi(vv.w); }
        }
    }
    const float inv = (mode == 0) ? 1.0f : 1.0f / lsum;
    GAS v4u* op = (GAS v4u*)(F_PQ + rowq * 1024 + qcol + 32 * hf);
#pragma unroll
    for (int i = 0; i < 4; ++i) { v4u w; w.x = pk2(o[8 * i + 0] * inv, o[8 * i + 1] * inv); w.y = pk2(o[8 * i + 2] * inv, o[8 * i + 3] * inv); w.z = pk2(o[8 * i + 4] * inv, o[8 * i + 5] * inv); w.w = pk2(o[8 * i + 6] * inv, o[8 * i + 7] * inv); op[i] = w; }
}
__device__ __forceinline__ void p_attn(Frame& F) {
    const int gw = F.vcu * NWAVES + F.wave, NGW = F.G * NWAVES;
#pragma unroll 1
    for (int mode = 0; mode < 4; ++mode)
#pragma unroll 1
        for (int r = gw; r < NB * 4 * 64; r += NGW) { const int bh = r >> 6; int qb = r & 63; if (mode & 1) qb = 63 - qb; attn_item(F, mode, bh >> 2, bh & 3, qb); }
}

__device__ __forceinline__ void p_fixup(Frame& F, int l) {
    const int gw = F.vcu * NWAVES + F.wave, NGW = F.G * NWAVES, lane = F.lane;
    const float* cw = inp(11) + (size_t)l * 3 * NUP; const float* cb = inp(12) + (size_t)l * NUP;
    typedef unsigned u32x2 __attribute__((ext_vector_type(2)));
    for (int it = gw; it < (MTOK / 64) * 11; it += NGW) {
        const int ck = it / 11, cbk = it % 11, f = cbk * 256 + lane * 4, c0 = ck * 64;
        const f32x4 wg0_ = *(const GAS f32x4*)(cw + f), wg1_ = *(const GAS f32x4*)(cw + NUP + f), wg2_ = *(const GAS f32x4*)(cw + 2 * NUP + f), bg = *(const GAS f32x4*)(cb + f);
        const f32x4 swg = *(const GAS f32x4*)(F_CMAXU + (size_t)l * NUP + f) * (1.0f / 127.0f), swu = *(const GAS f32x4*)(F_CMAXU + (size_t)l * NUP + DFF + f) * (1.0f / 127.0f);
        const f32x4 wu0 = *(const GAS f32x4*)(cw + DFF + f) * swu, wu1 = *(const GAS f32x4*)(cw + NUP + DFF + f) * swu, wu2 = *(const GAS f32x4*)(cw + 2 * NUP + DFF + f) * swu, bu = *(const GAS f32x4*)(cb + DFF + f);
        const f32x4 wg0 = wg0_ * swg, wg1 = wg1_ * swg, wg2 = wg2_ * swg;
        auto ld4 = [](const GAS unsigned short* p) -> f32x4 { const u32x2 raw = *(const GAS u32x2*)p; return (f32x4){bflo(raw.x), bfhi(raw.x), bflo(raw.y), bfhi(raw.y)}; };
        const GAS unsigned short* hb = (const GAS unsigned short*)F_HALO + (size_t)ck * 4 * NUP + f;
        f32x4 gm2 = (f32x4){0.f, 0.f, 0.f, 0.f}, gm1 = gm2, um2 = gm2, um1 = gm2;
        if ((c0 & (SEQ - 1)) != 0) { gm2 = ld4(hb - 2 * (size_t)NUP); gm1 = ld4(hb - (size_t)NUP); um2 = ld4(hb - 2 * (size_t)NUP + DFF); um1 = ld4(hb - (size_t)NUP + DFF); }
        const f32x4 g0 = ld4(hb), g1 = ld4(hb + NUP), u0 = ld4(hb + DFF), u1 = ld4(hb + NUP + DFF);
        const f32x4 cg0 = bg + wg0 * gm2 + wg1 * gm1 + wg2 * g0, cu0 = bu + wu0 * um2 + wu1 * um1 + wu2 * u0;
        const f32x4 cg1 = bg + wg0 * gm1 + wg1 * g0 + wg2 * g1, cu1 = bu + wu0 * um1 + wu1 * u0 + wu2 * u1;
        GAS unsigned short* ob = (GAS unsigned short*)F_ACT + (((size_t)(c0 >> 8) * (DFF / 64) + (f >> 6)) * 256 + (c0 & 255)) * 64 + (f & 63);
        {   const pg8::f32x2 a = pg8::gelu_pk((pg8::f32x2){cg0[0], cg0[1]}), c2 = pg8::gelu_pk((pg8::f32x2){cg0[2], cg0[3]});
            u32x2 w; w.x = pk2(a.x * cu0[0], a.y * cu0[1]); w.y = pk2(c2.x * cu0[2], c2.y * cu0[3]); *(GAS u32x2*)ob = w; }
        {   const pg8::f32x2 a = pg8::gelu_pk((pg8::f32x2){cg1[0], cg1[1]}), c2 = pg8::gelu_pk((pg8::f32x2){cg1[2], cg1[3]});
            u32x2 w; w.x = pk2(a.x * cu1[0], a.y * cu1[1]); w.y = pk2(c2.x * cu1[2], c2.y * cu1[3]); *(GAS u32x2*)(ob + 64) = w; }
    }
}

#ifndef STAGGER_PCT
#define STAGGER_PCT 0
#endif
__device__ __forceinline__ void stagger(const Frame& F, int ticks) { if (STAGGER_PCT > 0 && (F.vcu & 1)) { const unsigned long long t0 = __builtin_amdgcn_s_memrealtime(); while (__builtin_amdgcn_s_memrealtime() - t0 < (unsigned long long)(ticks * STAGGER_PCT / 100)) __builtin_amdgcn_s_sleep(16); } }
__device__ __forceinline__ void run_layer(Frame& F, const int l, const int lo, const int hi, const XcdBarrier& bar, const int vcu0, unsigned char* const ws0, const int wave0) {
#define GRID_BAR() do { if (MK_N_LAUNCHES == 1) xcd_barrier(bar); } while (0)
#define IN(k) (lo <= (k) && (k) < hi)
#define BOTH(k) (IN(k) && IN((k) + 1))
#define FRESH() do { int w_s = wave0; asm volatile("" : "+s"(w_s)); int l_; asm volatile("v_mbcnt_lo_u32_b32 %0, -1, 0\n\tv_mbcnt_hi_u32_b32 %0, -1, %0" : "=v"(l_)); F.tid = (w_s << 6) + l_; F.lane = l_; F.wave = w_s;     int v_ = vcu0; asm volatile("" : "+s"(v_)); F.vcu = v_; unsigned char* w_ = ws0; asm volatile("" : "+s"(w_)); F.ws = w_; } while (0)
        const int g0 = l * NP;
        if (hi <= g0 || lo >= g0 + NP) return;
        const size_t wofs = (l & 1) ? WS_WALT : 0;
        if (IN(g0 + 0)) { FRESH(); if (l == 0) { p_wmax(F); GRID_BAR(); p_wconv(F, 0, 0); p_init(F); } else p_quant0(F); if (BOTH(g0 + 0)) GRID_BAR(); }
        if (IN(g0 + 1)) { FRESH();
            pg8::Gemm g{(const bf16*)F_X8, (const bf16*)F_WIN8, MTOK, NPROJ, DM / 2, DM / 2, -1, 0, 0};   pg8::StaticOrder S; S.init(MTOK, NPROJ, F.G, (int)blockIdx.x);
            pg8::EpiProjS8 E{F_PQ, (size_t)(WS_PK - WS_PQ) / 2, F_SSA1, F_SX, F_SWIN}; stagger(F, 2800);
#pragma unroll 1
            for (int rep_ = 0; rep_ < ((PROBE_MASK >> 1) & 1) + 1; ++rep_) { if (rep_) GRID_BAR();
            pg8::gemm_phase<pg8::EpiProjS8, pg8::StaticOrder, true, true, true>(F.lds + RING_OFF, g, S, E, F.tid); }
            if (BOTH(g0 + 1)) GRID_BAR();
        }
        if (IN(g0 + 2)) { FRESH();
#if PROBE_MASK & 4
            if (l + 1 < DEPTH) p_wconv(F, l + 1, ((l + 1) & 1) ? WS_WALT : 0); p_quant(F, l); p_prep(F, l); GRID_BAR();
#endif
            if (l + 1 < DEPTH) p_wconv(F, l + 1, ((l + 1) & 1) ? WS_WALT : 0); p_quant(F, l); p_prep(F, l); if (BOTH(g0 + 2)) GRID_BAR(); }
        if (IN(g0 + 3)) { FRESH();
#if defined(NAIVE_ATTN)
            p_attn(F);
#else
#if PROBE_MASK & 8
            p_attn_mfma(F, (bf16*)(F.ws + 320 * MiB)); GRID_BAR();
#endif
            p_attn_mfma(F, F_PQ);
#endif
 if (BOTH(g0 + 3)) GRID_BAR(); }
        if (IN(g0 + 4)) { FRESH();
            pg8::Gemm g{F_PQ, F_WbT, MTOK, 4096, 256, 1024, 2, 0, 0}; pg8::StaticOrder S; S.init(MTOK, 4096, F.G, (int)blockIdx.x);
            pg8::EpiBvQ8 E{F_BVQ}; stagger(F, 1600);
#if PROBE_MASK & 2048
            { pg8::EpiNull E0{}; pg8::gemm_phase<pg8::EpiNull, pg8::StaticOrder, true, true>(F.lds + RING_OFF, g, S, E0, F.tid); GRID_BAR(); }
#endif
#if PROBE_MASK & 8192
            { pg8::EpiHalf E0{F_BV, 4096}; pg8::gemm_phase<pg8::EpiHalf, pg8::StaticOrder, true, true>(F.lds + RING_OFF, g, S, E0, F.tid); GRID_BAR(); }
#endif
#if PROBE_MASK & 4096
            { pg8::EpiBf16T E0{F_BV, 4096, F.lds + AUX_OFF}; pg8::gemm_phase<pg8::EpiBf16T, pg8::StaticOrder, true, true>(F.lds + RING_OFF, g, S, E0, F.tid); GRID_BAR(); }
#endif
#pragma unroll 1
            for (int rep_ = 0; rep_ < ((PROBE_MASK >> 4) & 1) + 1; ++rep_) { if (rep_) GRID_BAR();
            pg8::gemm_phase<pg8::EpiBvQ8, pg8::StaticOrder, true, true>(F.lds + RING_OFF, g, S, E, F.tid); }
            if (BOTH(g0 + 4)) GRID_BAR();
        }
        if (IN(g0 + 5)) { FRESH();
            pg8::Gemm g{(const bf16*)F_X8, (const bf16*)F_WG8, MTOK, 4096, DM / 2, DM / 2, -1, 0, 0};   pg8::StaticOrder S; S.init(MTOK, 4096, F.G, (int)blockIdx.x);
            pg8::EpiGateMix8 E{F_BVQ, F_MIX, F_SSA1, F_SX, (const unsigned*)(F_CTL + CW_WMAXG + l)}; stagger(F, 3000);
#pragma unroll 1
            for (int rep_ = 0; rep_ < ((PROBE_MASK >> 5) & 1) + 1; ++rep_) { if (rep_) GRID_BAR();
            pg8::gemm_phase<pg8::EpiGateMix8, pg8::StaticOrder, true, true, true>(F.lds + RING_OFF, g, S, E, F.tid); }
            if (BOTH(g0 + 5)) GRID_BAR();
        }
        if (IN(g0 + 6)) { FRESH();
            pg8::Gemm g{F_MIX, F_WoT, MTOK, DM, DM, DM, -1, 0, 0}; pg8::StaticOrder S; S.init(MTOK, DM, F.G, (int)blockIdx.x);
            pg8::EpiResB E{F_XB, DM, F_SSB, (LAS float*)(F.lds + AUX_OFF)}; stagger(F, 2600);
#if (PROBE_MASK & 64)
            { pg8::EpiResB E0{(bf16*)(F.ws + 320 * MiB), DM, (float*)(F.ws + 384 * MiB), (LAS float*)(F.lds + AUX_OFF)}; pg8::gemm_phase<pg8::EpiResB, pg8::StaticOrder, true, true>(F.lds + RING_OFF, g, S, E0, F.tid); GRID_BAR(); }
#endif
            pg8::gemm_phase<pg8::EpiResB, pg8::StaticOrder, true, true>(F.lds + RING_OFF, g, S, E, F.tid);
            if (BOTH(g0 + 6)) GRID_BAR();
        }
        if (IN(g0 + 7)) { FRESH(); p_quant1(F); if (BOTH(g0 + 7)) GRID_BAR(); }
        if (IN(g0 + 8)) { FRESH();
            pg8::Gemm g{(const bf16*)F_X18, (const bf16*)F_WUP8, MTOK, NUP, DM / 2, DM / 2, -1, 0, 0};   pg8::StaticOrder S; S.init(MTOK, NUP, F.G, (int)blockIdx.x);
            pg8::EpiConvGelu8 E{F_ACT, F_HALO, inp(11) + (size_t)l * 3 * NUP, inp(12) + (size_t)l * NUP, F_SSB1, F_SX1, F_CMAXU + (size_t)l * NUP}; stagger(F, 2800);
#pragma unroll 1
            for (int rep_ = 0; rep_ < ((PROBE_MASK >> 8) & 1) + 1; ++rep_) { if (rep_) GRID_BAR();
            pg8::gemm_phase<pg8::EpiConvGelu8, pg8::StaticOrder, true, true, true>(F.lds + RING_OFF, g, S, E, F.tid); }
            if (BOTH(g0 + 8)) GRID_BAR();
        }
        if (IN(g0 + 9)) { FRESH(); p_fixup(F, l); if (BOTH(g0 + 9)) GRID_BAR(); }
        if (IN(g0 + 10)) { FRESH();
            pg8::Gemm g{F_ACT, F_WdT, MTOK, DM, DFF, 64, -1, (size_t)32768, (size_t)(DFF / 64) * 32768};   pg8::StaticOrder S; S.init(MTOK, DM, F.G, (int)blockIdx.x);
            pg8::EpiResB E{F_XB, DM, F_SSA, (LAS float*)(F.lds + AUX_OFF)}; stagger(F, 6000);
#if (PROBE_MASK & 1024)
            { pg8::EpiResBT<(PROBE_MASK & 512) == 0> E0{(bf16*)(F.ws + 320 * MiB), DM, (float*)(F.ws + 384 * MiB), (LAS float*)(F.lds + AUX_OFF)}; pg8::gemm_phase<pg8::EpiResBT<(PROBE_MASK & 512) == 0>, pg8::StaticOrder, true, true>(F.lds + RING_OFF, g, S, E0, F.tid); GRID_BAR(); }
#endif
            pg8::gemm_phase<pg8::EpiResB, pg8::StaticOrder, true, true>(F.lds + RING_OFF, g, S, E, F.tid);
            if (BOTH(g0 + 10)) GRID_BAR();
        }

#undef IN
#undef BOTH
#undef GRID_BAR
#undef FRESH
}

__global__ void __launch_bounds__(NWAVES * 64, 2) fwd(Args args) {
    extern __shared__ __attribute__((aligned(16))) unsigned char lds[];
    Frame F;
    F.lds = (LAS unsigned char*)lds;
    F.MISC = (volatile LAS unsigned*)(F.lds + MISC_OFF);
    F.tid = threadIdx.x; F.lane = F.tid & 63; F.wave = __builtin_amdgcn_readfirstlane(F.tid >> 6);
    F.G = gridDim.x; { const int bx = blockIdx.x; F.vcu = (F.G % 8 == 0) ? (bx % 8) * (F.G / 8) + bx / 8 : bx; }
    F.ws = args.ws; const int vcu0 = F.vcu, wave0 = F.wave; unsigned char* const ws0 = args.ws;
    for (int u = F.tid; u < (LDS_BYTES - LDSCTL_OFF) / 4; u += NWAVES * 64) ((LAS unsigned*)(F.lds + LDSCTL_OFF))[u] = 0u;
    for (int u = F.tid; u < 8 * 129; u += NWAVES * 64) { const int hh = u / 129, n = u % 129; int bk;
        if (n < 16) bk = n; else if (n >= 128) bk = 31; else { bk = 16 + (n >= 19) + (n >= 21) + (n >= 24) + (n >= 27) + (n >= 31) + (n >= 35) + (n >= 40) + (n >= 46) + (n >= 52) + (n >= 59) + (n >= 67) + (n >= 77) + (n >= 87) + (n >= 99) + (n >= 113); }
        const float tv = inp(6)[bk * 8 + hh]; ((LAS float*)(F.lds + LUT_OFF))[hh * LUT_STRIDE + n] = tv; ((LAS float*)(F.lds + LUT2_OFF))[hh * LUT_STRIDE + n] = tv * 1.4426950408889634f; }
    __syncthreads();
    XcdBarrier bar; bar.bar = (unsigned*)(F_CTL + CW_BAR); bar.x = 0; bar.st = nullptr;
    if (MK_N_LAUNCHES == 1) bar = xcd_barrier_post((unsigned*)(F_CTL + CW_BAR), F.MISC + 8);
#define GRID_BAR() do { if (MK_N_LAUNCHES == 1) xcd_barrier(bar); } while (0)
    const int lo = args.g_lo, hi = args.g_hi;
#define IN(k) (lo <= (k) && (k) < hi)
#define FRESH() do { int w_s = wave0; asm volatile("" : "+s"(w_s)); int l_; asm volatile("v_mbcnt_lo_u32_b32 %0, -1, 0\n\tv_mbcnt_hi_u32_b32 %0, -1, %0" : "=v"(l_)); F.tid = (w_s << 6) + l_; F.lane = l_; F.wave = w_s;     int v_ = vcu0; asm volatile("" : "+s"(v_)); F.vcu = v_; unsigned char* w_ = ws0; asm volatile("" : "+s"(w_)); F.ws = w_; } while (0)
#define BOTH(k) (IN(k) && IN((k) + 1))
#pragma unroll 1
    for (int l = 0; l < DEPTH; ++l) run_layer(F, l, lo, hi, bar, vcu0, ws0, wave0);
    if (IN(DEPTH * NP)) { FRESH(); p_final(F, outp(), inp(3)); }
#undef IN
#undef FRESH
#undef BOTH
#undef GRID_BAR
}

extern "C" void kernel_launch(void* const* d_in, const int* in_sizes, int n_in, void* d_out, int out_size, void* d_ws, size_t ws_size, hipStream_t stream) {
    static int grid = 0;
    if (grid == 0) {
        if (n_in != 14 || out_size != MTOK * DM || ws_size < WS_END) { fprintf(stderr, "kernel_launch: unexpected shapes (n_in %d, out %d, ws %zu)\n", n_in, out_size, ws_size); grid = -1; return; }
        int dev = 0, cus = 0, per_cu = 0;
        if (hipGetDevice(&dev) != hipSuccess || hipDeviceGetAttribute(&cus, hipDeviceAttributeMultiprocessorCount, dev) != hipSuccess) { grid = -1; return; }
        if (hipFuncSetAttribute((const void*)fwd, hipFuncAttributeMaxDynamicSharedMemorySize, LDS_BYTES) != hipSuccess) { fprintf(stderr, "kernel_launch: hipFuncSetAttribute failed\n"); grid = -1; return; }
        if (hipOccupancyMaxActiveBlocksPerMultiprocessor(&per_cu, (const void*)fwd, NWAVES * 64, LDS_BYTES) != hipSuccess || per_cu < 1) fprintf(stderr, "kernel_launch: occupancy query reports %d\n", per_cu);
        (void)hipGetLastError();
        if (cus != 256) { fprintf(stderr, "kernel_launch: %d CUs (the phases deal whole rounds to a grid of 256 workgroups)\n", cus); grid = -1; return; }
        grid = cus;
    }
    if (grid < 0) return;
    if (hipMemsetAsync((char*)d_ws + WS_CTL, 0, CTL_ZERO_BYTES, stream) != hipSuccess) return;
    Args a{};
    for (int i = 0; i < 14; ++i) a.in[i] = (const float*)d_in[i];
    a.out = (float*)d_out; a.ws = (unsigned char*)d_ws;
#if MK_N_LAUNCHES == 1
    a.g_lo = 0; a.g_hi = NPH; a.li = 0;
    hipLaunchKernelGGL(fwd, dim3(grid), dim3(NWAVES * 64), LDS_BYTES, stream, a);
#else
    for (int g = 0; g < NPH; ++g) { a.g_lo = g; a.g_hi = g + 1; a.li = g; hipLaunchKernelGGL(fwd, dim3(grid), dim3(NWAVES * 64), LDS_BYTES, stream, a); }
#endif
}
```
